# Optimizing an MI355X kernel written in HIP

```python
import math
import jax, jax.numpy as jnp
from jax import lax
import numpy as np

D_MODEL = 2048
BATCH = 2
SEQ = 4096
DEPTH = 4

LRU_WIDTH = D_MODEL // 2
LRU_HEADS = 16
LRU_BLOCK = LRU_WIDTH // LRU_HEADS
CONV_WIDTH = 4
LRU_C = 8.0
SWA_HEAD_DIM = 64
SWA_Q_HEADS = (D_MODEL // 2) // SWA_HEAD_DIM
SWA_KV_HEADS = 2
SWA_GROUP = SWA_Q_HEADS // SWA_KV_HEADS
WINDOW = 128
QBLOCK = 128
REL_BUCKETS = 32
REL_MAX_DIST = 128
GLA_HEADS = 4
GLA_DK = D_MODEL // 2
GLA_DV = D_MODEL
GLA_HK = GLA_DK // GLA_HEADS
GLA_HV = GLA_DV // GLA_HEADS
GLA_RANK = 16
GLA_TAU = 16.0
GLA_CHUNK = 64
D_FF = 5632
DN_ALPHA = (2.0 * DEPTH) ** 0.25
DN_BETA = (8.0 * DEPTH) ** -0.25
LN_EPS = 1e-5
RMS_EPS = 1e-6

N_EVEN = (DEPTH + 1) // 2
N_ODD = DEPTH // 2
SWA_Q_W = SWA_Q_HEADS * SWA_HEAD_DIM
SWA_KV_W = SWA_KV_HEADS * SWA_HEAD_DIM
EVEN_IN = 2 * LRU_WIDTH + SWA_Q_W + 2 * SWA_KV_W
EVEN_MIX = LRU_WIDTH + SWA_Q_W
ODD_IN = 2 * GLA_DK + 2 * GLA_DV + GLA_RANK

kernel_name = "hybrid_rglru_swa_gla_macaron_deepnorm"


def layer_norm(x, g, b):
    xf = x.astype(jnp.float32)
    mu = jnp.mean(xf, -1, keepdims=True)
    var = jnp.mean(jnp.square(xf - mu), -1, keepdims=True)
    y = (xf - mu) * lax.rsqrt(var + LN_EPS) * g.astype(jnp.float32) + b.astype(jnp.float32)
    return y.astype(x.dtype)


def swiglu(x, w_gate, w_up, w_down):
    return (jax.nn.silu(x @ w_gate) * (x @ w_up)) @ w_down


def causal_conv(x, w, b):
    y = lax.conv_general_dilated(x, w[:, None, :], window_strides=(1,),
                                 padding=[(CONV_WIDTH - 1, 0)],
                                 dimension_numbers=('NWC', 'WIO', 'NWC'),
                                 feature_group_count=x.shape[-1])
    return y + b


def _lin_combine(c1, c2):
    a1, b1 = c1
    a2, b2 = c2
    return a1 * a2, a2 * b1 + b2


def rg_lru(xc, wa, ba, wx, bx, lam):
    B, T, W = xc.shape
    f32 = jnp.float32
    xf = xc.astype(f32)
    xb = xf.reshape(B, T, LRU_HEADS, LRU_BLOCK)
    r = jax.nn.sigmoid(jnp.einsum('bthi,hij->bthj', xb, wa.astype(f32)).reshape(B, T, W) + ba.astype(f32))
    i = jax.nn.sigmoid(jnp.einsum('bthi,hij->bthj', xb, wx.astype(f32)).reshape(B, T, W) + bx.astype(f32))
    log_a = -LRU_C * r * jax.nn.softplus(-lam.astype(f32))
    a = jnp.exp(log_a)
    u = jnp.sqrt(-jnp.expm1(2.0 * log_a)) * (i * xf)
    _, h = lax.associative_scan(_lin_combine, (a, u), axis=1)
    return h.astype(xc.dtype)


def t5_bucket(dist):
    max_exact = REL_BUCKETS // 2
    d = jnp.maximum(dist, 0)
    large = max_exact + (jnp.log(jnp.maximum(d, 1).astype(jnp.float32) / max_exact)
                         / math.log(REL_MAX_DIST / max_exact) * (REL_BUCKETS - max_exact)).astype(jnp.int32)
    large = jnp.minimum(large, REL_BUCKETS - 1)
    return jnp.where(d < max_exact, d, large)


def swa_attention(q, k, v, sinks, rel_bias):
    B, T, _ = q.shape
    nb = T // QBLOCK
    f32 = jnp.float32
    qb = q.astype(f32).reshape(B, nb, QBLOCK, SWA_KV_HEADS, SWA_GROUP, SWA_HEAD_DIM)
    def band(t):
        tp = jnp.pad(t.astype(f32), ((0, 0), (QBLOCK, 0), (0, 0)))
        tp = tp.reshape(B, nb + 1, QBLOCK, SWA_KV_HEADS, SWA_HEAD_DIM)
        return jnp.concatenate([tp[:, :-1], tp[:, 1:]], axis=2)
    kb, vb = band(k), band(v)
    s = jnp.einsum('bnqhgd,bnkhd->bnhgqk', qb, kb) * (SWA_HEAD_DIM ** -0.5)
    qi = jnp.arange(QBLOCK)[:, None]
    kj = jnp.arange(2 * QBLOCK)[None, :]
    dist = qi + QBLOCK - kj
    bias = rel_bias.astype(f32)[t5_bucket(dist)]
    bias = jnp.transpose(bias, (2, 0, 1)).reshape(SWA_KV_HEADS, SWA_GROUP, QBLOCK, 2 * QBLOCK)
    key_abs = jnp.arange(nb)[:, None, None] * QBLOCK + kj[None] - QBLOCK
    mask = (dist >= 0)[None] & (dist < WINDOW)[None] & (key_abs >= 0)
    s = jnp.where(mask[None, :, None, None], s + bias, -jnp.inf)
    sink = sinks.astype(f32).reshape(SWA_KV_HEADS, SWA_GROUP)[:, :, None, None]
    m = jnp.maximum(jnp.max(s, -1, keepdims=True), sink)
    p = jnp.exp(s - m)
    p = p / (jnp.sum(p, -1, keepdims=True) + jnp.exp(sink - m))
    o = jnp.einsum('bnhgqk,bnkhd->bnqhgd', p, vb)
    return o.reshape(B, T, SWA_Q_W).astype(q.dtype)


def even_mixer(h, w_in, conv_w, conv_b, wa, ba, wx, bx, lam, sinks, w_out, rel_bias):
    proj = h @ w_in
    cuts = [LRU_WIDTH, 2 * LRU_WIDTH, 2 * LRU_WIDTH + SWA_Q_W, 2 * LRU_WIDTH + SWA_Q_W + SWA_KV_W]
    xa, ga, q, k, v = jnp.split(proj, cuts, axis=-1)
    ya = jax.nn.gelu(ga) * rg_lru(causal_conv(xa, conv_w, conv_b), wa, ba, wx, bx, lam)
    yb = swa_attention(q, k, v, sinks, rel_bias)
    return jnp.concatenate([ya, yb], axis=-1) @ w_out


def gla_chunked(q, k, v, log_g):
    B, T, H, dk = q.shape
    dv = v.shape[-1]
    nc = T // GLA_CHUNK
    f32 = jnp.float32
    def to_chunks(t):
        t = t.astype(f32).reshape(B, nc, GLA_CHUNK, H, t.shape[-1])
        return jnp.transpose(t, (1, 0, 3, 2, 4))
    causal = jnp.tril(jnp.ones((GLA_CHUNK, GLA_CHUNK), bool))
    def step(S, inp):
        qc, kc, vc, gc = inp
        b = jnp.cumsum(gc, axis=2)
        o_inter = jnp.einsum('bhcd,bhde->bhce', qc * jnp.exp(b), S)
        diff = b[:, :, :, None, :] - b[:, :, None, :, :]
        decay = jnp.exp(jnp.where(causal[:, :, None], diff, -jnp.inf))
        A = jnp.einsum('bhtd,bhsd,bhtsd->bhts', qc, kc, decay)
        o_intra = jnp.einsum('bhts,bhse->bhte', A, vc)
        b_last = b[:, :, -1:, :]
        S = jnp.exp(b_last[:, :, 0, :])[..., None] * S + \
            jnp.einsum('bhcd,bhce->bhde', kc * jnp.exp(b_last - b), vc)
        return S, o_inter + o_intra
    S0 = jnp.zeros((B, H, dk, dv), f32)
    _, o = lax.scan(step, S0, (to_chunks(q) * (dk ** -0.5), to_chunks(k), to_chunks(v), to_chunks(log_g)))
    return jnp.transpose(o, (1, 0, 3, 2, 4)).reshape(B, T, H, dv)


def odd_mixer(h, w_in, w_alpha2, b_alpha, norm_g, w_out):
    B, T, _ = h.shape
    proj = h @ w_in
    cuts = [GLA_DK, 2 * GLA_DK, 2 * GLA_DK + GLA_DV, 2 * GLA_DK + 2 * GLA_DV]
    q, k, v, r, a_lr = jnp.split(proj, cuts, axis=-1)
    alpha_logit = (a_lr @ w_alpha2 + b_alpha).astype(jnp.float32)
    log_g = jax.nn.log_sigmoid(alpha_logit) / GLA_TAU
    o = gla_chunked(q.reshape(B, T, GLA_HEADS, GLA_HK), k.reshape(B, T, GLA_HEADS, GLA_HK),
                    v.reshape(B, T, GLA_HEADS, GLA_HV), log_g.reshape(B, T, GLA_HEADS, GLA_HK))
    o = o * lax.rsqrt(jnp.mean(jnp.square(o), -1, keepdims=True) + RMS_EPS) * norm_g.astype(jnp.float32)
    o = o.reshape(B, T, GLA_DV).astype(h.dtype) * jax.nn.silu(r)
    return o @ w_out


def setup_inputs(seed: int = 0) -> dict:
    key = jax.random.key(seed)
    ks = jax.random.split(key, 24)
    f32 = jnp.float32
    def nrm(k, shape, scale):
        return jax.random.normal(k, shape, f32) * scale
    u = jax.random.uniform(ks[10], (N_EVEN, LRU_WIDTH), f32, 0.9, 0.999)
    s = u ** (1.0 / LRU_C)
    lru_lambda = jnp.log(s / (1.0 - s))
    return {
        "x": nrm(ks[0], (BATCH, SEQ, D_MODEL), 1.0),
        "ffn_w_gate": nrm(ks[1], (DEPTH, 2, D_MODEL, D_FF), D_MODEL ** -0.5),
        "ffn_w_up": nrm(ks[2], (DEPTH, 2, D_MODEL, D_FF), D_MODEL ** -0.5),
        "ffn_w_down": nrm(ks[3], (DEPTH, 2, D_FF, D_MODEL), DN_BETA * D_FF ** -0.5),
        "ln_g": 1.0 + nrm(ks[4], (DEPTH, 3, D_MODEL), 0.02),
        "ln_b": nrm(ks[5], (DEPTH, 3, D_MODEL), 0.02),
        "even_w_in": nrm(ks[6], (N_EVEN, D_MODEL, EVEN_IN), D_MODEL ** -0.5),
        "conv_w": nrm(ks[7], (N_EVEN, CONV_WIDTH, LRU_WIDTH), CONV_WIDTH ** -0.5),
        "conv_b": nrm(ks[8], (N_EVEN, LRU_WIDTH), 0.02),
        "lru_wa": nrm(ks[9], (N_EVEN, LRU_HEADS, LRU_BLOCK, LRU_BLOCK), LRU_BLOCK ** -0.5),
        "lru_ba": nrm(ks[11], (N_EVEN, LRU_WIDTH), 0.02),
        "lru_wx": nrm(ks[12], (N_EVEN, LRU_HEADS, LRU_BLOCK, LRU_BLOCK), LRU_BLOCK ** -0.5),
        "lru_bx": nrm(ks[13], (N_EVEN, LRU_WIDTH), 0.02),
        "lru_lambda": lru_lambda,
        "swa_sinks": nrm(ks[14], (N_EVEN, SWA_Q_HEADS), 1.0),
        "even_w_out": nrm(ks[15], (N_EVEN, EVEN_MIX, D_MODEL), DN_BETA * EVEN_MIX ** -0.5),
        "rel_bias": nrm(ks[16], (REL_BUCKETS, SWA_Q_HEADS), 0.5),
        "odd_w_in": nrm(ks[17], (N_ODD, D_MODEL, ODD_IN), D_MODEL ** -0.5),
        "gla_w_alpha2": nrm(ks[18], (N_ODD, GLA_RANK, GLA_DK), GLA_RANK ** -0.5),
        "gla_b_alpha": nrm(ks[19], (N_ODD, GLA_DK), 0.02),
        "gla_norm_g": 1.0 + nrm(ks[20], (N_ODD, GLA_HV), 0.02),
        "odd_w_out": nrm(ks[21], (N_ODD, GLA_DV, D_MODEL), DN_BETA * GLA_DV ** -0.5),
    }


def reference(x, ffn_w_gate, ffn_w_up, ffn_w_down, ln_g, ln_b, even_w_in, conv_w, conv_b,
              lru_wa, lru_ba, lru_wx, lru_bx, lru_lambda, swa_sinks, even_w_out, rel_bias,
              odd_w_in, gla_w_alpha2, gla_b_alpha, gla_norm_g, odd_w_out):
    for l in range(DEPTH):
        ff = swiglu(x, ffn_w_gate[l, 0], ffn_w_up[l, 0], ffn_w_down[l, 0])
        x = layer_norm(DN_ALPHA * x + 0.5 * ff, ln_g[l, 0], ln_b[l, 0])
        j = l // 2
        if l % 2 == 0:
            mix = even_mixer(x, even_w_in[j], conv_w[j], conv_b[j], lru_wa[j], lru_ba[j],
                             lru_wx[j], lru_bx[j], lru_lambda[j], swa_sinks[j], even_w_out[j], rel_bias)
        else:
            mix = odd_mixer(x, odd_w_in[j], gla_w_alpha2[j], gla_b_alpha[j], gla_norm_g[j], odd_w_out[j])
        x = layer_norm(DN_ALPHA * x + mix, ln_g[l, 1], ln_b[l, 1])
        ff = swiglu(x, ffn_w_gate[l, 1], ffn_w_up[l, 1], ffn_w_down[l, 1])
        x = layer_norm(DN_ALPHA * x + 0.5 * ff, ln_g[l, 2], ln_b[l, 2])
    return x
```

```cpp
#include <hip/hip_runtime.h>
#include <cstdio>
#include <cstdint>
namespace pg8 {
#define PG8_LAS __attribute__((address_space(3)))
typedef unsigned short bf16_t;
typedef short bf16x8 __attribute__((ext_vector_type(8)));
typedef float f32x4 __attribute__((ext_vector_type(4)));
typedef unsigned u32x4 __attribute__((ext_vector_type(4)));
constexpr int BM = 256, BK = 64, HALF = 128, HTB = HALF * BK * 2  , STAGE_BYTES = 8 * HTB, NXCD = 8, WGM = 8;

__host__ __device__ __forceinline__ int lds_byte(int r, int c) { const int st = (r >> 4) * 2 + (c >> 5), rr = r & 15, cc = c & 31, ob = rr * 64 + cc * 2; return st * 1024 + (ob ^ (((ob >> 9) & 1) << 5)); }
__host__ __device__ __forceinline__ void stage_rc(int b, int& R, int& C) { const int st = b / 1024, sb = b % 1024, swz = sb ^ (((sb >> 9) & 1) << 5); R = (st >> 1) * 16 + swz / 64; C = (st & 1) * 32 + (swz % 64) / 2; }
__host__ __device__ __forceinline__ int perm32(int rho) { const int n = rho >> 4, i = rho & 15; return 8 * (i >> 2) + 4 * n + (i & 3); }

struct Unit { int pm, pn; };
struct Gemm { const bf16_t* A; const bf16_t* Bt; int M, N, K; };

struct StaticOrder {
    int nM, nN, nwg, G, c;
    __host__ __device__ void init(int M, int N, int G_, int c_) { nM = M / BM; nN = N / BM; nwg = nM * nN; G = G_; c = c_; }
    __host__ __device__ bool next(int i, Unit& u) const {
        const long L = (long)i * G + c; if (L >= nwg) return false;
        int wgid = (int)L; { const int q = nwg / NXCD, r = nwg % NXCD, xcd = wgid % NXCD, off = wgid / NXCD; wgid = (xcd < r ? xcd * (q + 1) : r * (q + 1) + (xcd - r) * q) + off; }
        const int nig = WGM * nN, gid = wgid / nig, fm = gid * WGM, gsz = (nM - fm) < WGM ? (nM - fm) : WGM;
        u.pm = fm + ((wgid % nig) % gsz); u.pn = (wgid % nig) / gsz; return true;
    }
    __device__ __forceinline__ void a_ready(const Unit&) const {}
    __device__ __forceinline__ void done(const Unit&) const {}
};

__device__ __forceinline__ unsigned cvt_pk_bf16(float lo, float hi) { unsigned r; asm volatile("v_cvt_pk_bf16_f32 %0, %1, %2" : "=v"(r) : "v"(lo), "v"(hi)); return r; }
typedef float f32x2 __attribute__((ext_vector_type(2)));
__device__ __forceinline__ float silu_f(float g) { return g * __builtin_amdgcn_rcpf(1.0f + __expf(-g)); }
struct EpiPlainBf16 {
    static constexpr bool PERM = true, AFTER_DRAIN = false;
    bf16_t* O; int ldc;
    __device__ __forceinline__ void operator()(const f32x4 (&acc)[2][2][4][2], const Unit& u, int wr, int wc, int fr, int fq) const {
        const int row0 = u.pm * BM + wr * 64 + fr, col0 = u.pn * BM + wc * 32 + 8 * fq;
#pragma unroll
        for (int ai = 0; ai < 2; ++ai)
#pragma unroll
            for (int m = 0; m < 4; ++m) { bf16_t* rowp = O + (size_t)(row0 + ai * HALF + m * 16) * ldc + col0;
#pragma unroll
                for (int bj = 0; bj < 2; ++bj) { const f32x4 v0 = acc[ai][bj][m][0], v1 = acc[ai][bj][m][1];
                    u32x4 w; w.x = cvt_pk_bf16(v0[0], v0[1]); w.y = cvt_pk_bf16(v0[2], v0[3]); w.z = cvt_pk_bf16(v1[0], v1[1]); w.w = cvt_pk_bf16(v1[2], v1[3]);
                    *(u32x4*)(rowp + bj * HALF) = w; } }
    }
};
struct EpiSwiGLU {
    static constexpr bool PERM = true, AFTER_DRAIN = false;
    bf16_t* O; int ldc;
    __device__ __forceinline__ void operator()(const f32x4 (&acc)[2][2][4][2], const Unit& u, int wr, int wc, int fr, int fq) const {
        const int row0 = u.pm * BM + wr * 64 + fr, col0 = u.pn * HALF + wc * 32 + 8 * fq;
#pragma unroll
        for (int ai = 0; ai < 2; ++ai)
#pragma unroll
            for (int m = 0; m < 4; ++m) { bf16_t* rowp = O + (size_t)(row0 + ai * HALF + m * 16) * ldc + col0;
                const f32x4 g0 = acc[ai][0][m][0], g1 = acc[ai][0][m][1], u0 = acc[ai][1][m][0], u1 = acc[ai][1][m][1];
                u32x4 w;
                w.x = cvt_pk_bf16(silu_f(g0[0]) * u0[0], silu_f(g0[1]) * u0[1]); w.y = cvt_pk_bf16(silu_f(g0[2]) * u0[2], silu_f(g0[3]) * u0[3]);
                w.z = cvt_pk_bf16(silu_f(g1[0]) * u1[0], silu_f(g1[1]) * u1[1]); w.w = cvt_pk_bf16(silu_f(g1[2]) * u1[2], silu_f(g1[3]) * u1[3]);
                *(u32x4*)rowp = w; }
    }
};
struct EpiResid {
    static constexpr bool PERM = false, AFTER_DRAIN = false;
    const float* R; float* Y; int ldc; float alpha, beta;
    __device__ __forceinline__ void operator()(const f32x4 (&acc)[2][2][4][2], const Unit& u, int wr, int wc, int fr, int fq) const {
        const int row0 = u.pm * BM + wr * 64 + fr, col0 = u.pn * BM + wc * 32 + 4 * fq;
#pragma unroll
        for (int ai = 0; ai < 2; ++ai)
#pragma unroll
            for (int m = 0; m < 4; ++m) { const size_t off = (size_t)(row0 + ai * HALF + m * 16) * ldc + col0;
#pragma unroll
                for (int bj = 0; bj < 2; ++bj)
#pragma unroll
                    for (int n = 0; n < 2; ++n) { const f32x4 r = *(const f32x4*)(R + off + bj * HALF + n * 16);
                        *(f32x4*)(Y + off + bj * HALF + n * 16) = r * alpha + acc[ai][bj][m][n] * beta; }
                asm volatile("" ::: "memory"); }
    }
};

template <class Epi, class Sched, bool ALIGN_EPI = false, bool SP2 = false>
__device__ __forceinline__ void gemm_phase(PG8_LAS unsigned char* lds, const Gemm g, const Sched& S, const Epi& E) {
    int tid_ = threadIdx.x; asm volatile("" : "+v"(tid_));
    const int tid = tid_, wid = __builtin_amdgcn_readfirstlane(tid >> 6), lane = tid & 63, wr = wid >> 2, wc = wid & 3, fr = lane & 15, fq = lane >> 4;
    const int K = g.K, nt = K / BK;
    unsigned voffA[2], voffB[2];
#pragma unroll
    for (int i = 0; i < 2; ++i) { int R, C; stage_rc(tid * 16 + i * 8192, R, C); const int Rb = Epi::PERM ? ((R & ~31) + perm32(R & 31)) : R;
        voffA[i] = (unsigned)(R * K + C) * 2u; voffB[i] = (unsigned)(Rb * K + C) * 2u; }
    const size_t kstep = (size_t)(BK * 2);
    const size_t hstep = (size_t)HALF * K * 2;
    const size_t tstep = 2 * hstep;
    const unsigned ldsw = (unsigned)wid * 1024u;
    const int aoff = lds_byte(wr * 64 + fr, fq * 8), boff = lds_byte(wc * 32 + fr, fq * 8);
#define PG8_SA(b, h) (((b) * 2 + (h)) * HTB)
#define PG8_SB(b, h) ((4 + (b) * 2 + (h)) * HTB)
#define PG8_STAGE(bufoff, gbase, voff) do { _Pragma("unroll") for (int _i = 0; _i < 2; ++_i) \
        __builtin_amdgcn_global_load_lds((const unsigned*)((const char*)(gbase) + (voff)[_i]), (PG8_LAS unsigned*)(lds + (bufoff) + ldsw + _i * 8192), 16, 0, 0); } while (0)
#define PG8_LDA(dst, b, h) do { _Pragma("unroll") for (int m = 0; m < 4; ++m) _Pragma("unroll") for (int k = 0; k < 2; ++k) dst[m][k] = *(const PG8_LAS bf16x8*)(lds + PG8_SA(b, h) + aoff + m * 2048 + k * 1024); } while (0)
#define PG8_LDB(dst, b, h) do { _Pragma("unroll") for (int n = 0; n < 2; ++n) _Pragma("unroll") for (int k = 0; k < 2; ++k) dst[n][k] = *(const PG8_LAS bf16x8*)(lds + PG8_SB(b, h) + boff + n * 2048 + k * 1024); } while (0)
#define PG8_MMA(ai, bj, At, Bt) do { __builtin_amdgcn_s_setprio(1); _Pragma("unroll") for (int m = 0; m < 4; ++m) _Pragma("unroll") for (int n = 0; n < 2; ++n) _Pragma("unroll") for (int k = 0; k < 2; ++k) \
        acc[ai][bj][m][n] = __builtin_amdgcn_mfma_f32_16x16x32_bf16(Bt[n][k], At[m][k], acc[ai][bj][m][n], 0, 0, 0); __builtin_amdgcn_s_setprio(0); } while (0)
#define PG8_WAIT_V(n) asm volatile("s_waitcnt vmcnt(" #n ")" ::: "memory")
#define PG8_WAIT_L(n) asm volatile("s_waitcnt lgkmcnt(" #n ")" ::: "memory")
#define PG8_BAR __builtin_amdgcn_s_barrier()
#define PG8_SCHED __builtin_amdgcn_sched_barrier(0)
    Unit cur, nxt; int ui = 0;
    if (!S.next(0, cur)) return;
    f32x4 acc[2][2][4][2];
#pragma unroll
    for (int a = 0; a < 2; ++a)
#pragma unroll
        for (int b = 0; b < 2; ++b)
#pragma unroll
            for (int m = 0; m < 4; ++m)
#pragma unroll
                for (int n = 0; n < 2; ++n) acc[a][b][m][n] = (f32x4){0.f, 0.f, 0.f, 0.f};
    bf16x8 At[4][2], B0[2][2], B1[2][2];
    const char* cA = (const char*)g.A + (size_t)cur.pm * tstep; const char* cB = (const char*)g.Bt + (size_t)cur.pn * tstep;
    S.a_ready(cur);
    if constexpr (SP2) {
        PG8_STAGE(PG8_SB(0, 0), cB, voffB); PG8_STAGE(PG8_SB(0, 1), cB + hstep, voffB); PG8_STAGE(PG8_SA(0, 0), cA, voffA); PG8_STAGE(PG8_SA(0, 1), cA + hstep, voffA);
        if (wr == 1) PG8_BAR;
        PG8_WAIT_V(2); PG8_BAR;
        PG8_STAGE(PG8_SB(1, 0), cB + kstep, voffB); PG8_STAGE(PG8_SA(1, 0), cA + kstep, voffA); PG8_STAGE(PG8_SB(1, 1), cB + hstep + kstep, voffB);
        PG8_WAIT_V(6); PG8_BAR;
    } else {
        PG8_STAGE(PG8_SB(0, 0), cB, voffB); PG8_STAGE(PG8_SA(0, 0), cA, voffA); PG8_STAGE(PG8_SB(0, 1), cB + hstep, voffB); PG8_STAGE(PG8_SA(0, 1), cA + hstep, voffA);
        if (wr == 1) PG8_BAR;
        PG8_WAIT_V(4); PG8_BAR;
        PG8_STAGE(PG8_SB(1, 0), cB + kstep, voffB); PG8_STAGE(PG8_SA(1, 0), cA + kstep, voffA); PG8_STAGE(PG8_SB(1, 1), cB + hstep + kstep, voffB);
        PG8_WAIT_V(6); PG8_BAR;
    }
    for (;;) {
        const bool has_next = S.next(ui + 1, nxt);
        const char* nA = has_next ? (const char*)g.A + (size_t)nxt.pm * tstep : cA; const char* nB = has_next ? (const char*)g.Bt + (size_t)nxt.pn * tstep : cB;
        for (int t = 0; t < nt; t += 2) {
            const bool last = (t == nt - 2);
            const char* a1 = cA + (size_t)(t + 1) * kstep;
            const char* a2 = last ? nA : cA + (size_t)(t + 2) * kstep; const char* b2 = last ? nB : cB + (size_t)(t + 2) * kstep;
            const char* a3 = a2 + kstep; const char* b3 = b2 + kstep;
            if (last && has_next) S.a_ready(nxt);
            if constexpr (SP2) {
            PG8_LDB(B0, 0, 0); PG8_LDB(B1, 0, 1); PG8_SCHED; PG8_LDA(At, 0, 0); PG8_STAGE(PG8_SA(1, 1), a1 + hstep, voffA);
            PG8_WAIT_V(8); PG8_WAIT_L(0); PG8_BAR; PG8_MMA(0, 0, At, B0); PG8_MMA(0, 1, At, B1); PG8_BAR; PG8_SCHED;
            PG8_LDA(At, 0, 1); PG8_STAGE(PG8_SB(0, 0), b2, voffB); PG8_STAGE(PG8_SB(0, 1), b2 + hstep, voffB); PG8_STAGE(PG8_SA(0, 0), a2, voffA);
            PG8_WAIT_V(8); PG8_WAIT_L(0); PG8_BAR; PG8_MMA(1, 0, At, B0); PG8_MMA(1, 1, At, B1); PG8_BAR; PG8_SCHED;
            PG8_LDB(B0, 1, 0); PG8_LDB(B1, 1, 1); PG8_SCHED; PG8_LDA(At, 1, 0); PG8_STAGE(PG8_SA(0, 1), a2 + hstep, voffA);
            PG8_WAIT_V(8); PG8_WAIT_L(0); PG8_BAR; PG8_MMA(0, 0, At, B0); PG8_MMA(0, 1, At, B1); PG8_BAR; PG8_SCHED;
            PG8_LDA(At, 1, 1); PG8_STAGE(PG8_SB(1, 0), b3, voffB); PG8_STAGE(PG8_SB(1, 1), b3 + hstep, voffB); PG8_STAGE(PG8_SA(1, 0), a3, voffA);
            PG8_WAIT_V(8); PG8_WAIT_L(0); PG8_BAR; PG8_MMA(1, 0, At, B0); PG8_MMA(1, 1, At, B1); PG8_BAR; PG8_SCHED;
            } else {
            PG8_LDB(B0, 0, 0); PG8_SCHED; PG8_LDA(At, 0, 0); PG8_STAGE(PG8_SA(1, 1), a1 + hstep, voffA);
            PG8_WAIT_L(8); PG8_BAR; PG8_WAIT_L(0); PG8_MMA(0, 0, At, B0); PG8_BAR; PG8_SCHED;
            PG8_LDB(B1, 0, 1); PG8_STAGE(PG8_SB(0, 0), b2, voffB);
            PG8_BAR; PG8_WAIT_L(0); PG8_MMA(0, 1, At, B1); PG8_BAR;
            PG8_LDA(At, 0, 1); PG8_STAGE(PG8_SA(0, 0), a2, voffA);
            PG8_BAR; PG8_WAIT_L(0); PG8_MMA(1, 0, At, B0); PG8_BAR; PG8_SCHED;
            PG8_STAGE(PG8_SB(0, 1), b2 + hstep, voffB);
            PG8_WAIT_V(6); PG8_BAR; PG8_MMA(1, 1, At, B1); PG8_BAR;
            PG8_LDB(B0, 1, 0); PG8_SCHED; PG8_LDA(At, 1, 0); PG8_STAGE(PG8_SA(0, 1), a2 + hstep, voffA);
            PG8_WAIT_L(8); PG8_BAR; PG8_WAIT_L(0); PG8_MMA(0, 0, At, B0); PG8_BAR; PG8_SCHED;
            PG8_LDB(B1, 1, 1); PG8_STAGE(PG8_SB(1, 0), b3, voffB);
            PG8_BAR; PG8_WAIT_L(0); PG8_MMA(0, 1, At, B1); PG8_BAR;
            PG8_LDA(At, 1, 1); PG8_STAGE(PG8_SA(1, 0), a3, voffA);
            PG8_BAR; PG8_WAIT_L(0); PG8_MMA(1, 0, At, B0); PG8_BAR; PG8_SCHED;
            PG8_STAGE(PG8_SB(1, 1), b3 + hstep, voffB);
            PG8_WAIT_V(6); PG8_BAR; PG8_MMA(1, 1, At, B1); PG8_BAR;
            }
        }
        if constexpr (ALIGN_EPI) { if (wr == 0) PG8_BAR; }
        if constexpr (!Epi::AFTER_DRAIN) { E(acc, cur, wr, wc, fr, fq); S.done(cur); }
        if (!has_next) break;
#pragma unroll
        for (int a = 0; a < 2; ++a)
#pragma unroll
            for (int b = 0; b < 2; ++b)
#pragma unroll
                for (int m = 0; m < 4; ++m)
#pragma unroll
                    for (int n = 0; n < 2; ++n) acc[a][b][m][n] = (f32x4){0.f, 0.f, 0.f, 0.f};
        cur = nxt; cA = nA; cB = nB; ++ui;
        if constexpr (ALIGN_EPI) { if (wr == 1) PG8_BAR; }
    }
    PG8_WAIT_V(0);
    if constexpr (!ALIGN_EPI) { if (wr == 0) PG8_BAR; }
    PG8_BAR;
    if constexpr (Epi::AFTER_DRAIN) { E.fused(acc, cur, wr, wc, fr, fq, lds, wid, lane); S.done(cur); }
#undef PG8_SA
#undef PG8_SB
#undef PG8_STAGE
#undef PG8_LDA
#undef PG8_LDB
#undef PG8_MMA
#undef PG8_WAIT_V
#undef PG8_WAIT_L
#undef PG8_BAR
#undef PG8_SCHED
}
}
#ifndef PG8_SP2
#define PG8_SP2 true
#endif
#ifndef PG8_ALIGN
#define PG8_ALIGN true
#endif
#ifndef MK_MULTI
#define MK_MULTI 1
#endif

constexpr int NWAVES = 8, NTHR = NWAVES * 64;
constexpr int BATCH = 2, T = 4096, D = 2048, M = BATCH * T, FF = 5632, DEPTH = 4;
constexpr int LRU_W = 1024, EVEN_IN = 3328, ODD_IN = 6160, ODD_N = 6144;
constexpr int GLA_DK = 1024, GLA_DV = 2048, GLA_HK = 256, GLA_HV = 512;
constexpr float DN_ALPHA = 1.6817928305074290f;
constexpr float LN_EPS = 1e-5f, RMS_EPS = 1e-6f;
constexpr int NSUB = 12, SLOTS = 6, NPHASE = 1 + NSUB * SLOTS;

constexpr size_t MiB = 1u << 20;
constexpr size_t WS_CTL = 0, CTL_ZERO_BYTES = 1 * MiB;
constexpr size_t WS_WGU = 1 * MiB, SZ_WGU = 44 * MiB;
constexpr size_t WS_WD = WS_WGU + 8 * SZ_WGU, SZ_WD = 22 * MiB;
constexpr size_t WS_WEIN = WS_WD + 8 * SZ_WD, SZ_WEIN = 13 * MiB;
constexpr size_t WS_WEOUT = WS_WEIN + 2 * SZ_WEIN, SZ_WOUT = 8 * MiB;
constexpr size_t WS_WOIN = WS_WEOUT + 2 * SZ_WOUT, SZ_WOIN = 24 * MiB;
constexpr size_t WS_WOOUT = WS_WOIN + 2 * SZ_WOIN;
constexpr size_t WS_X = WS_WOOUT + 2 * SZ_WOUT;
constexpr size_t WS_Y = WS_X + 64 * MiB;
constexpr size_t WS_XB = WS_Y + 64 * MiB;
constexpr size_t WS_H = WS_XB + 32 * MiB;
constexpr size_t WS_PROJ = WS_H + 88 * MiB;
constexpr size_t WS_MIX = WS_PROJ + 96 * MiB;
constexpr size_t WS_S0 = WS_MIX + 32 * MiB;
constexpr size_t WS_LRU_A = WS_S0, WS_LRU_U = WS_S0 + 32 * MiB, WS_LRU_SUM = WS_S0 + 64 * MiB;
constexpr size_t WS_GLA_ALR = WS_S0, WS_GLA_G = WS_S0 + 1 * MiB, WS_GLA_O = WS_S0 + 33 * MiB;
constexpr size_t WS_END = WS_S0 + 97 * MiB;
constexpr int CW_TMO = 0, CW_CODE = 1, CW_BAR = 4096;

constexpr int RING_OFF = 0, RING_BYTES = 131072;
constexpr int LDSCTL_OFF = RING_BYTES, MISC_OFF = LDSCTL_OFF + 320, SCR_OFF = LDSCTL_OFF + 512;
constexpr int LDS_BYTES = 147456;

#define GAS __attribute__((address_space(1)))
#define LAS __attribute__((address_space(3)))
typedef unsigned short bf16;
typedef unsigned v4u __attribute__((ext_vector_type(4)));
typedef unsigned v2u __attribute__((ext_vector_type(2)));
typedef float f32x4 __attribute__((ext_vector_type(4)));
typedef GAS unsigned gu32;
#define RLX_AGENT __ATOMIC_RELAXED, __HIP_MEMORY_SCOPE_AGENT
#define LDS_WAIT() asm volatile("s_waitcnt lgkmcnt(0)" ::: "memory")
#define VM_WAIT() asm volatile("s_waitcnt vmcnt(0)" ::: "memory")
__device__ __forceinline__ unsigned f2bf(float f) { unsigned u = __builtin_bit_cast(unsigned, f); return (u + 0x7fffu + ((u >> 16) & 1u)) >> 16; }
__device__ __forceinline__ unsigned pk2(float lo, float hi) { return f2bf(lo) | (f2bf(hi) << 16); }
__device__ __forceinline__ float bflo(unsigned w) { return __builtin_bit_cast(float, w << 16); }
__device__ __forceinline__ float bfhi(unsigned w) { return __builtin_bit_cast(float, w & 0xffff0000u); }
__device__ __forceinline__ float bf2f(bf16 b) { return __builtin_bit_cast(float, (unsigned)b << 16); }
__device__ __forceinline__ float sigmoid_f(float x) { return 1.0f / (1.0f + __expf(-x)); }

#define XB_TMO      128
#define XB_XCNT(j)  (256  + 64 * (j))
#define XB_XSUB(j)  (1280 + 64 * (j))
#define XB_XGEN(j)  (2304 + 64 * (j))
#define XB_TOP      3328
#define XB_TOPGEN   3392
#define XCD_BAR_WORDS 3456
#define XB_SPIN_CAP (1u << 18)

__device__ __forceinline__ unsigned xb_ld(unsigned* p)              { return __hip_atomic_load(p, __ATOMIC_RELAXED, __HIP_MEMORY_SCOPE_AGENT); }
__device__ __forceinline__ unsigned xb_add(unsigned* p, unsigned v) { return __hip_atomic_fetch_add(p, v, __ATOMIC_RELAXED, __HIP_MEMORY_SCOPE_AGENT); }
__device__ __forceinline__ unsigned xb_xcc_id() { return (unsigned)__builtin_amdgcn_s_getreg((3 << 11) | 20) & 0xFu; }
#define XB_SPIN(cond, bar) do { unsigned _sp = 0; while (cond) { __builtin_amdgcn_s_sleep(1); \
    if ((++_sp & 255u) == 0u) { if (xb_ld(&(bar)[XB_TMO])) break; if (_sp > XB_SPIN_CAP) { atomicAdd(&(bar)[XB_TMO], 1u); break; } } } } while (0)

struct XcdBarrier {
    unsigned* bar; unsigned x;
    volatile LAS unsigned* st;
};

__device__ __forceinline__ XcdBarrier xcd_barrier_post(unsigned* bar, volatile LAS unsigned* st) {
    XcdBarrier b; b.bar = bar; b.x = xb_xcc_id(); b.st = st;
    if (threadIdx.x == 0) (void)xb_add(&bar[XB_XCNT(b.x)], 1u);
    return b;
}
__device__ __forceinline__ void xcd_barrier_complete(unsigned* bar, unsigned x, unsigned& nloc, unsigned& nx) {
    const unsigned G = gridDim.x * gridDim.y * gridDim.z;
    unsigned sum, cnt, mine, sp = 0u;
    for (;;) {
        sum = 0u; cnt = 0u; mine = 0u;
#pragma unroll
        for (unsigned j = 0; j < 16; ++j) { const unsigned c = xb_ld(&bar[XB_XCNT(j)]); sum += c; cnt += (c > 0u) ? 1u : 0u; mine = (j == x) ? c : mine; }
        if (sum == G) break;
        __builtin_amdgcn_s_sleep(1);
        if ((++sp & 255u) == 0u) { if (xb_ld(&bar[XB_TMO])) break; if (sp > XB_SPIN_CAP) { atomicAdd(&bar[XB_TMO], 1u); break; } }
    }
    nloc = mine > 0u ? mine : 1u; nx = cnt > 0u ? cnt : 1u;
}

__device__ __forceinline__ void xcd_barrier(const XcdBarrier& b) {
    asm volatile("s_waitcnt vmcnt(0)" ::: "memory");
    __syncthreads();
    if (threadIdx.x == 0) {
        unsigned* bar = b.bar;
        __builtin_amdgcn_s_waitcnt(0);
        unsigned nloc = b.st[0], nx = b.st[1];
        if (nloc == 0u) { xcd_barrier_complete(bar, b.x, nloc, nx); b.st[0] = nloc; b.st[1] = nx; }
        const unsigned old = xb_add(&bar[XB_XSUB(b.x)], 1u);
        const unsigned gen = old / nloc;
        if (old + 1u == (gen + 1u) * nloc) {
            __builtin_amdgcn_fence(__ATOMIC_RELEASE, "agent");
            asm volatile("s_waitcnt vmcnt(0)" ::: "memory");
            const unsigned og = xb_add(&bar[XB_TOP], 1u);
            const unsigned tg = og / nx;
            if (og + 1u == (tg + 1u) * nx) xb_add(&bar[XB_TOPGEN], 1u);
            else XB_SPIN(xb_ld(&bar[XB_TOPGEN]) == tg, bar);
            __builtin_amdgcn_fence(__ATOMIC_ACQUIRE, "agent");
            xb_add(&bar[XB_XGEN(b.x)], 1u);
            asm volatile("s_waitcnt vmcnt(0)" ::: "memory");
        } else {
            XB_SPIN(xb_ld(&bar[XB_XGEN(b.x)]) == gen, bar);
            __builtin_amdgcn_fence(__ATOMIC_ACQUIRE, "agent");
            asm volatile("s_waitcnt vmcnt(0)" ::: "memory");
        }
    }
    __syncthreads();
}


struct Frame {
    LAS unsigned char* lds;
    volatile LAS unsigned* MISC;
    gu32* ctl;
    int tid, lane, wave, vcu, G;
    const float *xin, *w_gate, *w_up, *w_down, *ln_g, *ln_b, *even_w_in, *conv_w, *conv_b, *lru_wa, *lru_ba, *lru_wx, *lru_bx, *lru_lambda, *swa_sinks, *even_w_out, *rel_bias,
                *odd_w_in, *gla_w_alpha2, *gla_b_alpha, *gla_norm_g, *odd_w_out;
    float* out;
    unsigned char* ws;
};
__device__ __forceinline__ float wave_sum(float v) {
#pragma unroll
    for (int o = 1; o < 64; o <<= 1) v += __shfl_xor(v, o);
    return v;
}

__device__ __forceinline__ void transpose_item(const float* W, int ldw, int k0, int n0, bf16* WT, int K, int dst_row0, LAS float* scr, int lane) {
#pragma unroll 8
    for (int i = 0; i < 32; ++i) { const int kk = 2 * i + (lane >> 5); scr[kk * 33 + (lane & 31)] = W[(size_t)(k0 + kk) * ldw + n0 + (lane & 31)]; }
    LDS_WAIT(); asm volatile("" ::: "memory");
    const int c = lane & 7;
#pragma unroll
    for (int j = 0; j < 4; ++j) { const int n = (lane >> 3) + 8 * j; const LAS float* s = scr + (8 * c) * 33 + n;
        v4u o; o.x = pk2(s[0 * 33], s[1 * 33]); o.y = pk2(s[2 * 33], s[3 * 33]); o.z = pk2(s[4 * 33], s[5 * 33]); o.w = pk2(s[6 * 33], s[7 * 33]);
        *(GAS v4u*)(WT + (size_t)(dst_row0 + n) * K + k0 + 8 * c) = o; }
    LDS_WAIT(); asm volatile("" ::: "memory");
}
__device__ __forceinline__ void p0_prologue(Frame& F) {
    LAS float* scr = (LAS float*)(F.lds + RING_OFF + F.wave * 16384);
    const int gw = F.vcu * NWAVES + F.wave, NGW = F.G * NWAVES;
    constexpr int I_FF = (D / 64) * (FF / 32);
    constexpr int I_EIN = (D / 64) * (EVEN_IN / 32);
    constexpr int I_SQ = (D / 64) * (D / 32);
    constexpr int I_OIN = (D / 64) * (ODD_N / 32);
    constexpr int R1 = 8 * I_FF, R2 = 2 * R1, R3 = 3 * R1, R4 = R3 + 2 * I_EIN, R5 = R4 + 2 * I_SQ, R6 = R5 + 2 * I_OIN, R7 = R6 + 2 * I_SQ;
    bf16* ws16 = (bf16*)F.ws;
    for (int it = gw; it < R7; it += NGW) {
        if (it < R2) {
            const int up = it >= R1, r = it - up * R1, mi = r / I_FF, q = r % I_FF, kb = q / (FF / 32), nb = q % (FF / 32), n0 = nb * 32;
            const float* W = (up ? F.w_up : F.w_gate) + (size_t)mi * D * FF;
            transpose_item(W, FF, kb * 64, n0, (bf16*)(F.ws + WS_WGU + (size_t)mi * SZ_WGU), D, 256 * (n0 >> 7) + (n0 & 127) + up * 128, scr, F.lane);
        } else if (it < R3) {
            const int r = it - R2, mi = r / I_FF, q = r % I_FF, kb = q / (D / 32), nb = q % (D / 32);
            transpose_item(F.w_down + (size_t)mi * FF * D, D, kb * 64, nb * 32, (bf16*)(F.ws + WS_WD + (size_t)mi * SZ_WD), FF, nb * 32, scr, F.lane);
        } else if (it < R4) {
            const int r = it - R3, mi = r / I_EIN, q = r % I_EIN, kb = q / (EVEN_IN / 32), nb = q % (EVEN_IN / 32);
            transpose_item(F.even_w_in + (size_t)mi * D * EVEN_IN, EVEN_IN, kb * 64, nb * 32, (bf16*)(F.ws + WS_WEIN + (size_t)mi * SZ_WEIN), D, nb * 32, scr, F.lane);
        } else if (it < R5) {
            const int r = it - R4, mi = r / I_SQ, q = r % I_SQ, kb = q / (D / 32), nb = q % (D / 32);
            transpose_item(F.even_w_out + (size_t)mi * D * D, D, kb * 64, nb * 32, (bf16*)(F.ws + WS_WEOUT + (size_t)mi * SZ_WOUT), D, nb * 32, scr, F.lane);
        } else if (it < R6) {
            const int r = it - R5, mi = r / I_OIN, q = r % I_OIN, kb = q / (ODD_N / 32), nb = q % (ODD_N / 32);
            transpose_item(F.odd_w_in + (size_t)mi * D * ODD_IN, ODD_IN, kb * 64, nb * 32, (bf16*)(F.ws + WS_WOIN + (size_t)mi * SZ_WOIN), D, nb * 32, scr, F.lane);
        } else {
            const int r = it - R6, mi = r / I_SQ, q = r % I_SQ, kb = q / (D / 32), nb = q % (D / 32);
            transpose_item(F.odd_w_out + (size_t)mi * D * D, D, kb * 64, nb * 32, (bf16*)(F.ws + WS_WOOUT + (size_t)mi * SZ_WOUT), D, nb * 32, scr, F.lane);
        }
    }
    (void)ws16;
    bf16* XB = (bf16*)(F.ws + WS_XB);
    for (int m = gw; m < M; m += NGW) {
        const GAS f32x4* xr = (const GAS f32x4*)(F.xin + (size_t)m * D) + F.lane;
        GAS v2u* o8 = (GAS v2u*)(XB + (size_t)m * D) + F.lane;
#pragma unroll
        for (int j = 0; j < 8; ++j) { const f32x4 v = xr[64 * j]; v2u o; o.x = pk2(v.x, v.y); o.y = pk2(v.z, v.w); o8[64 * j] = o; }
    }
}

__device__ __forceinline__ void ln_phase(Frame& F, const float* Y, const float* g, const float* b, float* Xout, bf16* XB) {
    const int gw = F.vcu * NWAVES + F.wave, NGW = F.G * NWAVES;
    for (int m = gw; m < M; m += NGW) {
        const GAS f32x4* yr = (const GAS f32x4*)(Y + (size_t)m * D) + F.lane;
        f32x4 v[8]; float s = 0.f;
#pragma unroll
        for (int j = 0; j < 8; ++j) { v[j] = yr[64 * j]; s += (v[j].x + v[j].y) + (v[j].z + v[j].w); }
        const float mean = wave_sum(s) * (1.f / D); float s2 = 0.f;
#pragma unroll
        for (int j = 0; j < 8; ++j) { v[j] = v[j] - mean; s2 += (v[j].x * v[j].x + v[j].y * v[j].y) + (v[j].z * v[j].z + v[j].w * v[j].w); }
        const float rstd = 1.f / sqrtf(wave_sum(s2) * (1.f / D) + LN_EPS);
        GAS f32x4* xo = (GAS f32x4*)(Xout + (size_t)m * D) + F.lane;
        GAS v2u* o8 = (GAS v2u*)(XB + (size_t)m * D) + F.lane;
        const GAS f32x4* gp = (const GAS f32x4*)g + F.lane; const GAS f32x4* bp = (const GAS f32x4*)b + F.lane;
#pragma unroll
        for (int j = 0; j < 8; ++j) { const f32x4 o = v[j] * rstd * gp[64 * j] + bp[64 * j]; xo[64 * j] = o; v2u w; w.x = pk2(o.x, o.y); w.y = pk2(o.z, o.w); o8[64 * j] = w; }
    }
}

__device__ __forceinline__ void lru_local_phase(Frame& F, int j) {
    LAS float* xin = (LAS float*)(F.lds + RING_OFF);
    LAS float* xc = xin + 67 * 64;
    LAS float* wa = xc + 64 * 65;
    LAS float* wx = wa + 4096;
    LAS float* sa = wx + 4096;
    LAS float* su = sa + 4096;
    const bf16* PROJ = (const bf16*)(F.ws + WS_PROJ);
    float* Abuf = (float*)(F.ws + WS_LRU_A); float* Ubuf = (float*)(F.ws + WS_LRU_U); float* SUM = (float*)(F.ws + WS_LRU_SUM);
    const float* cw = F.conv_w + (size_t)j * 4 * LRU_W; const float* cb = F.conv_b + (size_t)j * LRU_W;
    const float* ba = F.lru_ba + (size_t)j * LRU_W; const float* bx = F.lru_bx + (size_t)j * LRU_W; const float* lam = F.lru_lambda + (size_t)j * LRU_W;
    const int tid = F.tid;
    for (int unit = blockIdx.x; unit < 2048; unit += F.G) {
        const int hh = unit & 15, c = (unit >> 4) & 63, b = unit >> 10, t0 = c * 64; const size_t mrow0 = (size_t)b * T + t0;
        for (int idx = tid; idx < 67 * 64; idx += NTHR) { const int r = idx >> 6, ch = idx & 63, t = t0 - 3 + r;
            xin[idx] = t >= 0 ? bf2f(PROJ[((size_t)b * T + t) * EVEN_IN + hh * 64 + ch]) : 0.f; }
        const float* gwa = F.lru_wa + ((size_t)j * 16 + hh) * 4096; const float* gwx = F.lru_wx + ((size_t)j * 16 + hh) * 4096;
        for (int idx = tid; idx < 4096; idx += NTHR) { wa[idx] = gwa[idx]; wx[idx] = gwx[idx]; }
        __syncthreads();
        for (int idx = tid; idx < 4096; idx += NTHR) { const int t = idx >> 6, ch = idx & 63, gch = hh * 64 + ch; float acc = cb[gch];
#pragma unroll
            for (int jj = 0; jj < 4; ++jj) acc += cw[jj * LRU_W + gch] * xin[(t + jj) * 64 + ch];
            xc[t * 65 + ch] = acc; }
        __syncthreads();
        {
            const int ch = tid & 63, tg = tid >> 6, gch = hh * 64 + ch;
            float ra[8], rx[8];
#pragma unroll
            for (int tt = 0; tt < 8; ++tt) { ra[tt] = 0.f; rx[tt] = 0.f; }
            for (int i = 0; i < 64; ++i) { const float wai = wa[i * 64 + ch], wxi = wx[i * 64 + ch];
#pragma unroll
                for (int tt = 0; tt < 8; ++tt) { const float xv = xc[(tg * 8 + tt) * 65 + i]; ra[tt] += xv * wai; rx[tt] += xv * wxi; } }
            const float sp = log1pf(expf(-lam[gch])), bav = ba[gch], bxv = bx[gch];
#pragma unroll
            for (int tt = 0; tt < 8; ++tt) { const int t = tg * 8 + tt;
                const float r = sigmoid_f(ra[tt] + bav), ig = sigmoid_f(rx[tt] + bxv), la = -8.0f * r * sp, a = expf(la), uu = sqrtf(-expm1f(2.0f * la)) * (ig * xc[t * 65 + ch]);
                sa[t * 64 + ch] = a; su[t * 64 + ch] = uu; Abuf[(mrow0 + t) * LRU_W + gch] = a; Ubuf[(mrow0 + t) * LRU_W + gch] = uu; }
        }
        __syncthreads();
        if (tid < 64) { float h = 0.f, P = 1.f;
            for (int t = 0; t < 64; ++t) { const float a = sa[t * 64 + tid]; h = a * h + su[t * 64 + tid]; P *= a; }
            float* sp2 = SUM + (((size_t)b * 64 + c) * LRU_W + hh * 64 + tid) * 2; sp2[0] = P; sp2[1] = h; }
        __syncthreads();
    }
}
__device__ __forceinline__ float gelu_tanh(float x) { const float u = 0.7978845608028654f * (x + 0.044715f * x * x * x); return 0.5f * x * (1.0f + tanhf(u)); }
__device__ __forceinline__ void lru_fix_phase(Frame& F) {
    const bf16* PROJ = (const bf16*)(F.ws + WS_PROJ); bf16* MIX = (bf16*)(F.ws + WS_MIX);
    const float* Abuf = (const float*)(F.ws + WS_LRU_A); const float* Ubuf = (const float*)(F.ws + WS_LRU_U); const float* SUM = (const float*)(F.ws + WS_LRU_SUM);
    for (int unit = blockIdx.x; unit < 256; unit += F.G) {
        const int half = unit & 1, c = (unit >> 1) & 63, b = unit >> 7, ch = half * 512 + F.tid;
        float h = 0.f;
        for (int cc = 0; cc < c; ++cc) { const float* sp2 = SUM + (((size_t)b * 64 + cc) * LRU_W + ch) * 2; h = sp2[0] * h + sp2[1]; }
        const size_t m0 = (size_t)b * T + c * 64;
        for (int t = 0; t < 64; ++t) { const size_t m = m0 + t; h = Abuf[m * LRU_W + ch] * h + Ubuf[m * LRU_W + ch];
            const float ga = bf2f(PROJ[m * EVEN_IN + LRU_W + ch]);
            MIX[m * D + ch] = (bf16)f2bf(gelu_tanh(ga) * h); }
    }
}
__device__ __forceinline__ void swa_phase(Frame& F, int j) {
    LAS float* Ks = (LAS float*)(F.lds + RING_OFF);
    LAS float* Vs = Ks + 256 * 64;
    LAS float* btab = (LAS float*)(F.lds + SCR_OFF);
    const bf16* PROJ = (const bf16*)(F.ws + WS_PROJ); bf16* MIX = (bf16*)(F.ws + WS_MIX);
    const int tid = F.tid, lane = F.lane, w = F.wave;
    for (int unit = blockIdx.x; unit < 256; unit += F.G) {
        const int half = unit & 1, kvh = (unit >> 1) & 1, nb = (unit >> 2) & 31, b = unit >> 7, hq = kvh * 8 + w;
        __syncthreads();
        for (int idx = tid; idx < 8 * 128; idx += NTHR) { const int hh = idx >> 7, d = idx & 127;
            int bucket = d; if (d >= 16) { bucket = 16 + (int)(logf((float)d * (1.0f / 16.0f)) / 2.0794415416798357f * 16.0f); bucket = bucket > 31 ? 31 : bucket; }
            btab[idx] = F.rel_bias[bucket * 16 + kvh * 8 + hh]; }
        for (int idx = tid; idx < 2048; idx += NTHR) { const int r = idx >> 3, c8 = idx & 7, kabs = nb * 128 + r - 128;
            v4u kk = (v4u){0u, 0u, 0u, 0u}, vv = (v4u){0u, 0u, 0u, 0u};
            if (kabs >= 0) { const bf16* rowp = PROJ + ((size_t)b * T + kabs) * EVEN_IN; kk = *(const GAS v4u*)(rowp + 3072 + kvh * 64 + c8 * 8); vv = *(const GAS v4u*)(rowp + 3200 + kvh * 64 + c8 * 8); }
            LAS float* kd = Ks + r * 64 + c8 * 8; LAS float* vd = Vs + r * 64 + c8 * 8;
            kd[0] = bflo(kk.x); kd[1] = bfhi(kk.x); kd[2] = bflo(kk.y); kd[3] = bfhi(kk.y); kd[4] = bflo(kk.z); kd[5] = bfhi(kk.z); kd[6] = bflo(kk.w); kd[7] = bfhi(kk.w);
            vd[0] = bflo(vv.x); vd[1] = bfhi(vv.x); vd[2] = bflo(vv.y); vd[3] = bfhi(vv.y); vd[4] = bflo(vv.z); vd[5] = bfhi(vv.z); vd[6] = bflo(vv.w); vd[7] = bfhi(vv.w); }
        __syncthreads();
        const int i = half * 64 + lane; const size_t m = (size_t)b * T + nb * 128 + i;
        float q[64], o[64];
        { const bf16* qp = PROJ + m * EVEN_IN + 2048 + hq * 64;
#pragma unroll
          for (int c8 = 0; c8 < 8; ++c8) { const v4u t = *(const GAS v4u*)(qp + c8 * 8);
              q[c8 * 8 + 0] = bflo(t.x) * 0.125f; q[c8 * 8 + 1] = bfhi(t.x) * 0.125f; q[c8 * 8 + 2] = bflo(t.y) * 0.125f; q[c8 * 8 + 3] = bfhi(t.y) * 0.125f;
              q[c8 * 8 + 4] = bflo(t.z) * 0.125f; q[c8 * 8 + 5] = bfhi(t.z) * 0.125f; q[c8 * 8 + 6] = bflo(t.w) * 0.125f; q[c8 * 8 + 7] = bfhi(t.w) * 0.125f; } }
#pragma unroll
        for (int d = 0; d < 64; ++d) o[d] = 0.f;
        float mx = F.swa_sinks[j * 16 + hq], l = 1.0f;
        const LAS float* bt = btab + w * 128;
        const int jlo = half * 64 + 1, jhi = half * 64 + 63 + 128;
        for (int jk = jlo; jk <= jhi; ++jk) {
            const LAS f32x4* kr = (const LAS f32x4*)(Ks + jk * 64); float s = 0.f;
#pragma unroll
            for (int c4 = 0; c4 < 16; ++c4) { const f32x4 kv = kr[c4]; s += q[c4 * 4] * kv.x + q[c4 * 4 + 1] * kv.y + q[c4 * 4 + 2] * kv.z + q[c4 * 4 + 3] * kv.w; }
            const int dist = i + 128 - jk; const bool ok = (dist >= 0) && (dist < 128) && (nb * 128 + jk - 128 >= 0);
            s = ok ? s + bt[dist & 127] : -__builtin_inff();
            const float mn = fmaxf(mx, s), sc = __expf(mx - mn), pe = __expf(s - mn);
            l = l * sc + pe; mx = mn;
            const LAS f32x4* vr = (const LAS f32x4*)(Vs + jk * 64);
#pragma unroll
            for (int c4 = 0; c4 < 16; ++c4) { const f32x4 vv = vr[c4]; o[c4 * 4] = o[c4 * 4] * sc + pe * vv.x; o[c4 * 4 + 1] = o[c4 * 4 + 1] * sc + pe * vv.y; o[c4 * 4 + 2] = o[c4 * 4 + 2] * sc + pe * vv.z; o[c4 * 4 + 3] = o[c4 * 4 + 3] * sc + pe * vv.w; }
        }
        const float inv = 1.0f / l;
        bf16* op = MIX + m * D + LRU_W + hq * 64;
#pragma unroll
        for (int c8 = 0; c8 < 8; ++c8) { v4u t; t.x = pk2(o[c8 * 8] * inv, o[c8 * 8 + 1] * inv); t.y = pk2(o[c8 * 8 + 2] * inv, o[c8 * 8 + 3] * inv); t.z = pk2(o[c8 * 8 + 4] * inv, o[c8 * 8 + 5] * inv); t.w = pk2(o[c8 * 8 + 6] * inv, o[c8 * 8 + 7] * inv);
            *(GAS v4u*)(op + c8 * 8) = t; }
    }
    __syncthreads();
}

__device__ __forceinline__ void gla_gate_phase(Frame& F, int j) {
    LAS float* alr = (LAS float*)(F.lds + RING_OFF);
    const float* X = (const float*)(F.ws + WS_X); float* G = (float*)(F.ws + WS_GLA_G);
    const float* W = F.odd_w_in + (size_t)j * D * ODD_IN + ODD_N;
    const float* w2 = F.gla_w_alpha2 + (size_t)j * 16 * GLA_DK; const float* bal = F.gla_b_alpha + (size_t)j * GLA_DK;
    const int tid = F.tid;
    for (int unit = blockIdx.x; unit < M / 32; unit += F.G) {
        __syncthreads();
        { const int r = tid & 15, row = tid >> 4; const float* xr = X + (size_t)(unit * 32 + row) * D; float acc = 0.f;
          for (int k = 0; k < D; k += 4) { const f32x4 xv = *(const GAS f32x4*)(xr + k);
              acc += xv.x * W[(size_t)k * ODD_IN + r] + xv.y * W[(size_t)(k + 1) * ODD_IN + r] + xv.z * W[(size_t)(k + 2) * ODD_IN + r] + xv.w * W[(size_t)(k + 3) * ODD_IN + r]; }
          alr[row * 16 + r] = acc; }
        __syncthreads();
#pragma unroll
        for (int jj = 0; jj < 2; ++jj) { const int d = tid + jj * NTHR; float wc[16];
#pragma unroll
            for (int r = 0; r < 16; ++r) wc[r] = w2[r * GLA_DK + d];
            const float bb = bal[d];
            for (int row = 0; row < 32; ++row) { float lg = bb;
#pragma unroll
                for (int r = 0; r < 16; ++r) lg += alr[row * 16 + r] * wc[r];
                const float ls = fminf(lg, 0.f) - log1pf(expf(-fabsf(lg)));
                G[(size_t)(unit * 32 + row) * GLA_DK + d] = expf(ls * (1.0f / 16.0f)); } }
    }
    __syncthreads();
}
__device__ __forceinline__ void gla_scan_phase(Frame& F) {
    LAS float* red = (LAS float*)(F.lds + RING_OFF);
    const bf16* PROJ = (const bf16*)(F.ws + WS_PROJ); const float* G = (const float*)(F.ws + WS_GLA_G); float* O = (float*)(F.ws + WS_GLA_O);
    const int tid = F.tid, lane = F.lane, w = F.wave, e = tid & 15, d0 = (tid >> 4) * 8;
    for (int unit = blockIdx.x; unit < 256; unit += F.G) {
        const int es = unit & 31, h = (unit >> 5) & 3, b = unit >> 7, e0 = es * 16;
        float S[8];
#pragma unroll
        for (int i = 0; i < 8; ++i) S[i] = 0.f;
        for (int tb = 0; tb < T; tb += 8) {
            f32x4 g0[8], g1[8]; v4u kk[8], qq[8]; float vv[8];
#pragma unroll
            for (int tt = 0; tt < 8; ++tt) { const size_t m = (size_t)b * T + tb + tt; const bf16* rowp = PROJ + m * ODD_N;
                g0[tt] = *(const GAS f32x4*)(G + m * GLA_DK + h * 256 + d0); g1[tt] = *(const GAS f32x4*)(G + m * GLA_DK + h * 256 + d0 + 4);
                qq[tt] = *(const GAS v4u*)(rowp + h * 256 + d0); kk[tt] = *(const GAS v4u*)(rowp + 1024 + h * 256 + d0); vv[tt] = bf2f(rowp[2048 + h * 512 + e0 + e]); }
            __syncthreads();
#pragma unroll
            for (int tt = 0; tt < 8; ++tt) {
                const float v = vv[tt]; float part;
                S[0] = g0[tt].x * S[0] + bflo(kk[tt].x) * v; part = bflo(qq[tt].x) * S[0];
                S[1] = g0[tt].y * S[1] + bfhi(kk[tt].x) * v; part += bfhi(qq[tt].x) * S[1];
                S[2] = g0[tt].z * S[2] + bflo(kk[tt].y) * v; part += bflo(qq[tt].y) * S[2];
                S[3] = g0[tt].w * S[3] + bfhi(kk[tt].y) * v; part += bfhi(qq[tt].y) * S[3];
                S[4] = g1[tt].x * S[4] + bflo(kk[tt].z) * v; part += bflo(qq[tt].z) * S[4];
                S[5] = g1[tt].y * S[5] + bfhi(kk[tt].z) * v; part += bfhi(qq[tt].z) * S[5];
                S[6] = g1[tt].z * S[6] + bflo(kk[tt].w) * v; part += bflo(qq[tt].w) * S[6];
                S[7] = g1[tt].w * S[7] + bfhi(kk[tt].w) * v; part += bfhi(qq[tt].w) * S[7];
                part += __shfl_xor(part, 16); part += __shfl_xor(part, 32);
                if (lane < 16) red[(tt * 8 + w) * 16 + lane] = part;
            }
            __syncthreads();
            if (tid < 128) { const int tt = tid >> 4, ee = tid & 15; float s = 0.f;
#pragma unroll
                for (int ww = 0; ww < 8; ++ww) s += red[(tt * 8 + ww) * 16 + ee];
                O[((size_t)b * T + tb + tt) * GLA_DV + h * 512 + e0 + ee] = s * (1.0f / 16.0f); }
        }
    }
    __syncthreads();
}
__device__ __forceinline__ void gla_post_phase(Frame& F, int j) {
    const bf16* PROJ = (const bf16*)(F.ws + WS_PROJ); const float* O = (const float*)(F.ws + WS_GLA_O); bf16* MIX = (bf16*)(F.ws + WS_MIX);
    const float* ng = F.gla_norm_g + (size_t)j * GLA_HV;
    const int gw = F.vcu * NWAVES + F.wave, NGW = F.G * NWAVES, lane = F.lane;
    const f32x4 n0 = *(const GAS f32x4*)(ng + lane * 8), n1 = *(const GAS f32x4*)(ng + lane * 8 + 4);
    for (int it = gw; it < M * 4; it += NGW) { const int h = it & 3; const size_t m = it >> 2;
        const f32x4 a = *(const GAS f32x4*)(O + m * GLA_DV + h * 512 + lane * 8), c = *(const GAS f32x4*)(O + m * GLA_DV + h * 512 + lane * 8 + 4);
        const v4u rr = *(const GAS v4u*)(PROJ + m * ODD_N + 4096 + h * 512 + lane * 8);
        const float ss = wave_sum((a.x * a.x + a.y * a.y) + (a.z * a.z + a.w * a.w) + (c.x * c.x + c.y * c.y) + (c.z * c.z + c.w * c.w));
        const float rs = 1.0f / sqrtf(ss * (1.0f / 512.0f) + RMS_EPS);
        float r[8] = {bflo(rr.x), bfhi(rr.x), bflo(rr.y), bfhi(rr.y), bflo(rr.z), bfhi(rr.z), bflo(rr.w), bfhi(rr.w)};
        float ov[8] = {a.x * rs * n0.x, a.y * rs * n0.y, a.z * rs * n0.z, a.w * rs * n0.w, c.x * rs * n1.x, c.y * rs * n1.y, c.z * rs * n1.z, c.w * rs * n1.w};
        float y[8];
#pragma unroll
        for (int i = 0; i < 8; ++i) y[i] = ov[i] * (r[i] * sigmoid_f(r[i]));
        v4u t; t.x = pk2(y[0], y[1]); t.y = pk2(y[2], y[3]); t.z = pk2(y[4], y[5]); t.w = pk2(y[6], y[7]);
        *(GAS v4u*)(MIX + m * D + h * 512 + lane * 8) = t; }
}

__host__ __device__ inline bool phase_active(int p) {
    if (p == 0) return true;
    const int s = (p - 1) / SLOTS, k = (p - 1) % SLOTS, l = s / 3, kind = s % 3;
    if (k == 0 || k == 4 || k == 5) return true;
    if (kind != 1) return false;
    if ((l & 1) == 0) return k == 1 || k == 2;
    return true;
}
struct Args { const float* in[22]; float* out; unsigned char* ws; int ph_lo, ph_hi; };
__global__ void __launch_bounds__(NTHR, 2) mk_fwd(Args args) {
    extern __shared__ __attribute__((aligned(16))) unsigned char lds[];
    Frame F;
    F.lds = (LAS unsigned char*)lds;
    F.MISC = (volatile LAS unsigned*)(F.lds + MISC_OFF);
    F.tid = threadIdx.x; F.lane = F.tid & 63; F.wave = __builtin_amdgcn_readfirstlane(F.tid >> 6);
    F.G = gridDim.x; { const int bx = blockIdx.x; F.vcu = (F.G % 8 == 0) ? (bx % 8) * (F.G / 8) + bx / 8 : bx; }
    F.ws = args.ws; F.ctl = (gu32*)(args.ws + WS_CTL); F.out = args.out;
    F.xin = args.in[0]; F.w_gate = args.in[1]; F.w_up = args.in[2]; F.w_down = args.in[3]; F.ln_g = args.in[4]; F.ln_b = args.in[5]; F.even_w_in = args.in[6]; F.conv_w = args.in[7]; F.conv_b = args.in[8];
    F.lru_wa = args.in[9]; F.lru_ba = args.in[10]; F.lru_wx = args.in[11]; F.lru_bx = args.in[12]; F.lru_lambda = args.in[13]; F.swa_sinks = args.in[14]; F.even_w_out = args.in[15]; F.rel_bias = args.in[16];
    F.odd_w_in = args.in[17]; F.gla_w_alpha2 = args.in[18]; F.gla_b_alpha = args.in[19]; F.gla_norm_g = args.in[20]; F.odd_w_out = args.in[21];
    for (int u = F.tid; u < (LDS_BYTES - LDSCTL_OFF) / 4; u += NTHR) ((LAS unsigned*)(F.lds + LDSCTL_OFF))[u] = 0u;
    __syncthreads();
#if MK_MULTI
#define GRID_BAR() do { } while (0)
#else
    XcdBarrier bar = xcd_barrier_post((unsigned*)(F.ctl + CW_BAR), F.MISC + 8);
#define GRID_BAR() xcd_barrier(bar)
#endif
    const int lo = args.ph_lo, hi = args.ph_hi;
#define IN(k) (lo <= (k) && (k) < hi)
#define REFRESH() do { int t_ = threadIdx.x; asm volatile("" : "+v"(t_)); F.tid = t_; F.lane = t_ & 63; F.wave = __builtin_amdgcn_readfirstlane(t_ >> 6); unsigned char* w_ = args.ws; asm volatile("" : "+s"(w_)); F.ws = w_; } while (0)
#define SEAM(k) do { if ((k) + 1 < hi) GRID_BAR(); } while (0)
#define X ((float*)(F.ws + WS_X))
#define Y ((float*)(F.ws + WS_Y))
#define XB ((bf16*)(F.ws + WS_XB))
#define H ((bf16*)(F.ws + WS_H))
#define PROJ ((bf16*)(F.ws + WS_PROJ))
#define MIX ((bf16*)(F.ws + WS_MIX))

    if (IN(0)) { REFRESH(); p0_prologue(F); SEAM(0); }

    for (int s = 0; s < NSUB; ++s) {
        const int l = s / 3, kind = s % 3, j = l >> 1, pb = 1 + s * SLOTS, odd = l & 1;
        const int fi = l * 2 + (kind == 2 ? 1 : 0);
        if (IN(pb + 0)) {
            REFRESH();
            if (kind != 1) {
                pg8::Gemm g{XB, (const bf16*)(F.ws + WS_WGU + (size_t)fi * SZ_WGU), M, 2 * FF, D}; pg8::StaticOrder S; S.init(M, 2 * FF, F.G, (int)blockIdx.x);
                pg8::EpiSwiGLU E{H, FF};
                pg8::gemm_phase<pg8::EpiSwiGLU, pg8::StaticOrder, PG8_ALIGN, PG8_SP2>(F.lds + RING_OFF, g, S, E);
            } else {
                const int N = odd ? ODD_N : EVEN_IN;
                const bf16* Wt = odd ? (const bf16*)(F.ws + WS_WOIN + (size_t)j * SZ_WOIN) : (const bf16*)(F.ws + WS_WEIN + (size_t)j * SZ_WEIN);
                pg8::Gemm g{XB, Wt, M, N, D}; pg8::StaticOrder S; S.init(M, N, F.G, (int)blockIdx.x);
                pg8::EpiPlainBf16 E{PROJ, N};
                pg8::gemm_phase<pg8::EpiPlainBf16, pg8::StaticOrder, PG8_ALIGN, PG8_SP2>(F.lds + RING_OFF, g, S, E);
            }
            SEAM(pb + 0);
        }
        if (kind == 1) {
            if (!odd) {
                if (IN(pb + 1)) { REFRESH(); lru_local_phase(F, j); REFRESH(); swa_phase(F, j); SEAM(pb + 1); }
                if (IN(pb + 2)) { REFRESH(); lru_fix_phase(F); SEAM(pb + 2); }
            } else {
                if (IN(pb + 1)) { REFRESH(); gla_gate_phase(F, j); SEAM(pb + 1); }
                if (IN(pb + 2)) { REFRESH(); gla_scan_phase(F); SEAM(pb + 2); }
                if (IN(pb + 3)) { REFRESH(); gla_post_phase(F, j); SEAM(pb + 3); }
            }
        }
        if (IN(pb + 4)) {
            REFRESH();
            const bf16* A = kind != 1 ? H : MIX; const int K = kind != 1 ? FF : D;
            const bf16* Wt = kind != 1 ? (const bf16*)(F.ws + WS_WD + (size_t)fi * SZ_WD) : (odd ? (const bf16*)(F.ws + WS_WOOUT + (size_t)j * SZ_WOUT) : (const bf16*)(F.ws + WS_WEOUT + (size_t)j * SZ_WOUT));
            pg8::Gemm g{A, Wt, M, D, K}; pg8::StaticOrder S; S.init(M, D, F.G, (int)blockIdx.x);
            pg8::EpiResid E{s == 0 ? F.xin : X, Y, D, DN_ALPHA, kind != 1 ? 0.5f : 1.0f};
            pg8::gemm_phase<pg8::EpiResid, pg8::StaticOrder, PG8_ALIGN, PG8_SP2>(F.lds + RING_OFF, g, S, E);
            SEAM(pb + 4);
        }
        if (IN(pb + 5)) {
            REFRESH();
            ln_phase(F, Y, F.ln_g + (size_t)(l * 3 + kind) * D, F.ln_b + (size_t)(l * 3 + kind) * D, s == NSUB - 1 ? F.out : X, XB);
            SEAM(pb + 5);
        }
    }
#undef IN
#undef SEAM
#undef X
#undef Y
#undef XB
#undef H
#undef PROJ
#undef MIX
}

extern "C" void kernel_launch(void* const* d_in, const int* in_sizes, int n_in, void* d_out, int out_size, void* d_ws, size_t ws_size, hipStream_t stream) {
    static int grid = 0;
    if (grid == 0) {
        if (n_in != 22 || in_sizes[0] != M * D || out_size != M * D || ws_size < WS_END) { fprintf(stderr, "kernel_launch: unexpected shapes (n_in %d, in0 %d, out %d, ws %zu < %zu); nothing launched\n", n_in, n_in > 0 ? in_sizes[0] : -1, out_size, ws_size, (size_t)WS_END); grid = -1; return; }
        int dev = 0, cus = 0, per_cu = 0;
        if (hipGetDevice(&dev) != hipSuccess || hipDeviceGetAttribute(&cus, hipDeviceAttributeMultiprocessorCount, dev) != hipSuccess) { grid = -1; return; }
        if (hipFuncSetAttribute((const void*)mk_fwd, hipFuncAttributeMaxDynamicSharedMemorySize, LDS_BYTES) != hipSuccess) { fprintf(stderr, "kernel_launch: hipFuncSetAttribute failed\n"); grid = -1; return; }
        if (hipOccupancyMaxActiveBlocksPerMultiprocessor(&per_cu, (const void*)mk_fwd, NTHR, LDS_BYTES) != hipSuccess || per_cu < 1) { fprintf(stderr, "kernel_launch: occupancy query says %d blocks per CU\n", per_cu); }
        (void)hipGetLastError();
        grid = cus;
    }
    if (grid < 0) return;
    (void)hipMemsetAsync((char*)d_ws + WS_CTL, 0, CTL_ZERO_BYTES, stream);
    Args a{};
    for (int i = 0; i < 22; ++i) a.in[i] = (const float*)d_in[i];
    a.out = (float*)d_out; a.ws = (unsigned char*)d_ws;
#if MK_MULTI
    for (int p = 0; p < NPHASE; ++p) { if (!phase_active(p)) continue; a.ph_lo = p; a.ph_hi = p + 1; hipLaunchKernelGGL(mk_fwd, dim3(grid), dim3(NTHR), LDS_BYTES, stream, a); }
#else
    a.ph_lo = 0; a.ph_hi = NPHASE; hipLaunchKernelGGL(mk_fwd, dim3(grid), dim3(NTHR), LDS_BYTES, stream, a);
#endif
    const hipError_t le = hipPeekAtLastError();
    if (le != hipSuccess) fprintf(stderr, "kernel_launch: launch failed: %s\n", hipGetErrorName(le));
}
```

```cpp
#include <hip/hip_runtime.h>
#include <cstdio>
#include <cstdint>
namespace pg8 {
#define PG8_LAS __attribute__((address_space(3)))
typedef unsigned short bf16_t;
typedef short bf16x8 __attribute__((ext_vector_type(8)));
typedef float f32x4 __attribute__((ext_vector_type(4)));
typedef unsigned u32x4 __attribute__((ext_vector_type(4)));
constexpr int BM = 256, BK = 64, HALF = 128, HTB = HALF * BK * 2  , STAGE_BYTES = 8 * HTB, NXCD = 8, WGM = 8;

__host__ __device__ __forceinline__ int lds_byte(int r, int c) { const int st = (r >> 4) * 2 + (c >> 5), rr = r & 15, cc = c & 31, ob = rr * 64 + cc * 2; return st * 1024 + (ob ^ (((ob >> 9) & 1) << 5)); }
__host__ __device__ __forceinline__ void stage_rc(int b, int& R, int& C) { const int st = b / 1024, sb = b % 1024, swz = sb ^ (((sb >> 9) & 1) << 5); R = (st >> 1) * 16 + swz / 64; C = (st & 1) * 32 + (swz % 64) / 2; }
__host__ __device__ __forceinline__ int perm32(int rho) { const int n = rho >> 4, i = rho & 15; return 8 * (i >> 2) + 4 * n + (i & 3); }

struct Unit { int pm, pn; };
struct Gemm { const bf16_t* A; const bf16_t* Bt; int M, N, K; };

struct StaticOrder {
    int nM, nN, nwg, G, c;
    __host__ __device__ void init(int M, int N, int G_, int c_) { nM = M / BM; nN = N / BM; nwg = nM * nN; G = G_; c = c_; }
    __host__ __device__ bool next(int i, Unit& u) const {
        const long L = (long)i * G + c; if (L >= nwg) return false;
        int wgid = (int)L; { const int q = nwg / NXCD, r = nwg % NXCD, xcd = wgid % NXCD, off = wgid / NXCD; wgid = (xcd < r ? xcd * (q + 1) : r * (q + 1) + (xcd - r) * q) + off; }
        const int nig = WGM * nN, gid = wgid / nig, fm = gid * WGM, gsz = (nM - fm) < WGM ? (nM - fm) : WGM;
        u.pm = fm + ((wgid % nig) % gsz); u.pn = (wgid % nig) / gsz; return true;
    }
    __device__ __forceinline__ void a_ready(const Unit&) const {}
    __device__ __forceinline__ void done(const Unit&) const {}
};

__device__ __forceinline__ unsigned cvt_pk_bf16(float lo, float hi) { unsigned r; asm volatile("v_cvt_pk_bf16_f32 %0, %1, %2" : "=v"(r) : "v"(lo), "v"(hi)); return r; }
typedef float f32x2 __attribute__((ext_vector_type(2)));
__device__ __forceinline__ float silu_f(float g) { return g * __builtin_amdgcn_rcpf(1.0f + __expf(-g)); }
struct EpiPlainBf16 {
    static constexpr bool PERM = true, AFTER_DRAIN = false;
    bf16_t* O; int ldc;
    __device__ __forceinline__ void operator()(const f32x4 (&acc)[2][2][4][2], const Unit& u, int wr, int wc, int fr, int fq) const {
        const int row0 = u.pm * BM + wr * 64 + fr, col0 = u.pn * BM + wc * 32 + 8 * fq;
#pragma unroll
        for (int ai = 0; ai < 2; ++ai)
#pragma unroll
            for (int m = 0; m < 4; ++m) { bf16_t* rowp = O + (size_t)(row0 + ai * HALF + m * 16) * ldc + col0;
#pragma unroll
                for (int bj = 0; bj < 2; ++bj) { const f32x4 v0 = acc[ai][bj][m][0], v1 = acc[ai][bj][m][1];
                    u32x4 w; w.x = cvt_pk_bf16(v0[0], v0[1]); w.y = cvt_pk_bf16(v0[2], v0[3]); w.z = cvt_pk_bf16(v1[0], v1[1]); w.w = cvt_pk_bf16(v1[2], v1[3]);
                    *(u32x4*)(rowp + bj * HALF) = w; } }
    }
};
struct EpiSwiGLU {
    static constexpr bool PERM = true, AFTER_DRAIN = false;
    bf16_t* O; int ldc;
    __device__ __forceinline__ void operator()(const f32x4 (&acc)[2][2][4][2], const Unit& u, int wr, int wc, int fr, int fq) const {
        const int row0 = u.pm * BM + wr * 64 + fr, col0 = u.pn * HALF + wc * 32 + 8 * fq;
#pragma unroll
        for (int ai = 0; ai < 2; ++ai)
#pragma unroll
            for (int m = 0; m < 4; ++m) { bf16_t* rowp = O + (size_t)(row0 + ai * HALF + m * 16) * ldc + col0;
                const f32x4 g0 = acc[ai][0][m][0], g1 = acc[ai][0][m][1], u0 = acc[ai][1][m][0], u1 = acc[ai][1][m][1];
                u32x4 w;
                w.x = cvt_pk_bf16(silu_f(g0[0]) * u0[0], silu_f(g0[1]) * u0[1]); w.y = cvt_pk_bf16(silu_f(g0[2]) * u0[2], silu_f(g0[3]) * u0[3]);
                w.z = cvt_pk_bf16(silu_f(g1[0]) * u1[0], silu_f(g1[1]) * u1[1]); w.w = cvt_pk_bf16(silu_f(g1[2]) * u1[2], silu_f(g1[3]) * u1[3]);
                *(u32x4*)rowp = w; }
    }
};
struct EpiResid {
    static constexpr bool PERM = false, AFTER_DRAIN = false;
    const float* R; float* Y; int ldc; float alpha, beta;
    __device__ __forceinline__ void operator()(const f32x4 (&acc)[2][2][4][2], const Unit& u, int wr, int wc, int fr, int fq) const {
        const int row0 = u.pm * BM + wr * 64 + fr, col0 = u.pn * BM + wc * 32 + 4 * fq;
#pragma unroll
        for (int ai = 0; ai < 2; ++ai)
#pragma unroll
            for (int m = 0; m < 4; ++m) { const size_t off = (size_t)(row0 + ai * HALF + m * 16) * ldc + col0;
#pragma unroll
                for (int bj = 0; bj < 2; ++bj)
#pragma unroll
                    for (int n = 0; n < 2; ++n) { const f32x4 r = *(const f32x4*)(R + off + bj * HALF + n * 16);
                        *(f32x4*)(Y + off + bj * HALF + n * 16) = r * alpha + acc[ai][bj][m][n] * beta; }
                asm volatile("" ::: "memory"); }
    }
};

template <class Epi, class Sched, bool ALIGN_EPI = false, bool SP2 = false>
__device__ __forceinline__ void gemm_phase(PG8_LAS unsigned char* lds, const Gemm g, const Sched& S, const Epi& E) {
    int tid_ = threadIdx.x; asm volatile("" : "+v"(tid_));
    const int tid = tid_, wid = __builtin_amdgcn_readfirstlane(tid >> 6), lane = tid & 63, wr = wid >> 2, wc = wid & 3, fr = lane & 15, fq = lane >> 4;
    const int K = g.K, nt = K / BK;
    unsigned voffA[2], voffB[2];
#pragma unroll
    for (int i = 0; i < 2; ++i) { int R, C; stage_rc(tid * 16 + i * 8192, R, C); const int Rb = Epi::PERM ? ((R & ~31) + perm32(R & 31)) : R;
        voffA[i] = (unsigned)(R * K + C) * 2u; voffB[i] = (unsigned)(Rb * K + C) * 2u; }
    const size_t kstep = (size_t)(BK * 2);
    const size_t hstep = (size_t)HALF * K * 2;
    const size_t tstep = 2 * hstep;
    const unsigned ldsw = (unsigned)wid * 1024u;
    const int aoff = lds_byte(wr * 64 + fr, fq * 8), boff = lds_byte(wc * 32 + fr, fq * 8);
#define PG8_SA(b, h) (((b) * 2 + (h)) * HTB)
#define PG8_SB(b, h) ((4 + (b) * 2 + (h)) * HTB)
#define PG8_STAGE(bufoff, gbase, voff) do { _Pragma("unroll") for (int _i = 0; _i < 2; ++_i) \
        __builtin_amdgcn_global_load_lds((const unsigned*)((const char*)(gbase) + (voff)[_i]), (PG8_LAS unsigned*)(lds + (bufoff) + ldsw + _i * 8192), 16, 0, 0); } while (0)
#define PG8_LDA(dst, b, h) do { _Pragma("unroll") for (int m = 0; m < 4; ++m) _Pragma("unroll") for (int k = 0; k < 2; ++k) dst[m][k] = *(const PG8_LAS bf16x8*)(lds + PG8_SA(b, h) + aoff + m * 2048 + k * 1024); } while (0)
#define PG8_LDB(dst, b, h) do { _Pragma("unroll") for (int n = 0; n < 2; ++n) _Pragma("unroll") for (int k = 0; k < 2; ++k) dst[n][k] = *(const PG8_LAS bf16x8*)(lds + PG8_SB(b, h) + boff + n * 2048 + k * 1024); } while (0)
#define PG8_MMA(ai, bj, At, Bt) do { __builtin_amdgcn_s_setprio(1); _Pragma("unroll") for (int m = 0; m < 4; ++m) _Pragma("unroll") for (int n = 0; n < 2; ++n) _Pragma("unroll") for (int k = 0; k < 2; ++k) \
        acc[ai][bj][m][n] = __builtin_amdgcn_mfma_f32_16x16x32_bf16(Bt[n][k], At[m][k], acc[ai][bj][m][n], 0, 0, 0); __builtin_amdgcn_s_setprio(0); } while (0)
#define PG8_WAIT_V(n) asm volatile("s_waitcnt vmcnt(" #n ")" ::: "memory")
#define PG8_WAIT_L(n) asm volatile("s_waitcnt lgkmcnt(" #n ")" ::: "memory")
#define PG8_BAR __builtin_amdgcn_s_barrier()
#define PG8_SCHED __builtin_amdgcn_sched_barrier(0)
    Unit cur, nxt; int ui = 0;
    if (!S.next(0, cur)) return;
    f32x4 acc[2][2][4][2];
#pragma unroll
    for (int a = 0; a < 2; ++a)
#pragma unroll
        for (int b = 0; b < 2; ++b)
#pragma unroll
            for (int m = 0; m < 4; ++m)
#pragma unroll
                for (int n = 0; n < 2; ++n) acc[a][b][m][n] = (f32x4){0.f, 0.f, 0.f, 0.f};
    bf16x8 At[4][2], B0[2][2], B1[2][2];
    const char* cA = (const char*)g.A + (size_t)cur.pm * tstep; const char* cB = (const char*)g.Bt + (size_t)cur.pn * tstep;
    S.a_ready(cur);
    if constexpr (SP2) {
        PG8_STAGE(PG8_SB(0, 0), cB, voffB); PG8_STAGE(PG8_SB(0, 1), cB + hstep, voffB); PG8_STAGE(PG8_SA(0, 0), cA, voffA); PG8_STAGE(PG8_SA(0, 1), cA + hstep, voffA);
        if (wr == 1) PG8_BAR;
        PG8_WAIT_V(2); PG8_BAR;
        PG8_STAGE(PG8_SB(1, 0), cB + kstep, voffB); PG8_STAGE(PG8_SA(1, 0), cA + kstep, voffA); PG8_STAGE(PG8_SB(1, 1), cB + hstep + kstep, voffB);
        PG8_WAIT_V(6); PG8_BAR;
    } else {
        PG8_STAGE(PG8_SB(0, 0), cB, voffB); PG8_STAGE(PG8_SA(0, 0), cA, voffA); PG8_STAGE(PG8_SB(0, 1), cB + hstep, voffB); PG8_STAGE(PG8_SA(0, 1), cA + hstep, voffA);
        if (wr == 1) PG8_BAR;
        PG8_WAIT_V(4); PG8_BAR;
        PG8_STAGE(PG8_SB(1, 0), cB + kstep, voffB); PG8_STAGE(PG8_SA(1, 0), cA + kstep, voffA); PG8_STAGE(PG8_SB(1, 1), cB + hstep + kstep, voffB);
        PG8_WAIT_V(6); PG8_BAR;
    }
    for (;;) {
        const bool has_next = S.next(ui + 1, nxt);
        const char* nA = has_next ? (const char*)g.A + (size_t)nxt.pm * tstep : cA; const char* nB = has_next ? (const char*)g.Bt + (size_t)nxt.pn * tstep : cB;
        for (int t = 0; t < nt; t += 2) {
            const bool last = (t == nt - 2);
            const char* a1 = cA + (size_t)(t + 1) * kstep;
            const char* a2 = last ? nA : cA + (size_t)(t + 2) * kstep; const char* b2 = last ? nB : cB + (size_t)(t + 2) * kstep;
            const char* a3 = a2 + kstep; const char* b3 = b2 + kstep;
            if (last && has_next) S.a_ready(nxt);
            if constexpr (SP2) {
            PG8_LDB(B0, 0, 0); PG8_LDB(B1, 0, 1); PG8_SCHED; PG8_LDA(At, 0, 0); PG8_STAGE(PG8_SA(1, 1), a1 + hstep, voffA);
            PG8_WAIT_V(8); PG8_WAIT_L(0); PG8_BAR; PG8_MMA(0, 0, At, B0); PG8_MMA(0, 1, At, B1); PG8_BAR; PG8_SCHED;
            PG8_LDA(At, 0, 1); PG8_STAGE(PG8_SB(0, 0), b2, voffB); PG8_STAGE(PG8_SB(0, 1), b2 + hstep, voffB); PG8_STAGE(PG8_SA(0, 0), a2, voffA);
            PG8_WAIT_V(8); PG8_WAIT_L(0); PG8_BAR; PG8_MMA(1, 0, At, B0); PG8_MMA(1, 1, At, B1); PG8_BAR; PG8_SCHED;
            PG8_LDB(B0, 1, 0); PG8_LDB(B1, 1, 1); PG8_SCHED; PG8_LDA(At, 1, 0); PG8_STAGE(PG8_SA(0, 1), a2 + hstep, voffA);
            PG8_WAIT_V(8); PG8_WAIT_L(0); PG8_BAR; PG8_MMA(0, 0, At, B0); PG8_MMA(0, 1, At, B1); PG8_BAR; PG8_SCHED;
            PG8_LDA(At, 1, 1); PG8_STAGE(PG8_SB(1, 0), b3, voffB); PG8_STAGE(PG8_SB(1, 1), b3 + hstep, voffB); PG8_STAGE(PG8_SA(1, 0), a3, voffA);
            PG8_WAIT_V(8); PG8_WAIT_L(0); PG8_BAR; PG8_MMA(1, 0, At, B0); PG8_MMA(1, 1, At, B1); PG8_BAR; PG8_SCHED;
            } else {
            PG8_LDB(B0, 0, 0); PG8_SCHED; PG8_LDA(At, 0, 0); PG8_STAGE(PG8_SA(1, 1), a1 + hstep, voffA);
            PG8_WAIT_L(8); PG8_BAR; PG8_WAIT_L(0); PG8_MMA(0, 0, At, B0); PG8_BAR; PG8_SCHED;
            PG8_LDB(B1, 0, 1); PG8_STAGE(PG8_SB(0, 0), b2, voffB);
            PG8_BAR; PG8_WAIT_L(0); PG8_MMA(0, 1, At, B1); PG8_BAR;
            PG8_LDA(At, 0, 1); PG8_STAGE(PG8_SA(0, 0), a2, voffA);
            PG8_BAR; PG8_WAIT_L(0); PG8_MMA(1, 0, At, B0); PG8_BAR; PG8_SCHED;
            PG8_STAGE(PG8_SB(0, 1), b2 + hstep, voffB);
            PG8_WAIT_V(6); PG8_BAR; PG8_MMA(1, 1, At, B1); PG8_BAR;
            PG8_LDB(B0, 1, 0); PG8_SCHED; PG8_LDA(At, 1, 0); PG8_STAGE(PG8_SA(0, 1), a2 + hstep, voffA);
            PG8_WAIT_L(8); PG8_BAR; PG8_WAIT_L(0); PG8_MMA(0, 0, At, B0); PG8_BAR; PG8_SCHED;
            PG8_LDB(B1, 1, 1); PG8_STAGE(PG8_SB(1, 0), b3, voffB);
            PG8_BAR; PG8_WAIT_L(0); PG8_MMA(0, 1, At, B1); PG8_BAR;
            PG8_LDA(At, 1, 1); PG8_STAGE(PG8_SA(1, 0), a3, voffA);
            PG8_BAR; PG8_WAIT_L(0); PG8_MMA(1, 0, At, B0); PG8_BAR; PG8_SCHED;
            PG8_STAGE(PG8_SB(1, 1), b3 + hstep, voffB);
            PG8_WAIT_V(6); PG8_BAR; PG8_MMA(1, 1, At, B1); PG8_BAR;
            }
        }
        if constexpr (ALIGN_EPI) { if (wr == 0) PG8_BAR; }
        if constexpr (!Epi::AFTER_DRAIN) { E(acc, cur, wr, wc, fr, fq); S.done(cur); }
        if (!has_next) break;
#pragma unroll
        for (int a = 0; a < 2; ++a)
#pragma unroll
            for (int b = 0; b < 2; ++b)
#pragma unroll
                for (int m = 0; m < 4; ++m)
#pragma unroll
                    for (int n = 0; n < 2; ++n) acc[a][b][m][n] = (f32x4){0.f, 0.f, 0.f, 0.f};
        cur = nxt; cA = nA; cB = nB; ++ui;
        if constexpr (ALIGN_EPI) { if (wr == 1) PG8_BAR; }
    }
    PG8_WAIT_V(0);
    if constexpr (!ALIGN_EPI) { if (wr == 0) PG8_BAR; }
    PG8_BAR;
    if constexpr (Epi::AFTER_DRAIN) { E.fused(acc, cur, wr, wc, fr, fq, lds, wid, lane); S.done(cur); }
#undef PG8_SA
#undef PG8_SB
#undef PG8_STAGE
#undef PG8_LDA
#undef PG8_LDB
#undef PG8_MMA
#undef PG8_WAIT_V
#undef PG8_WAIT_L
#undef PG8_BAR
#undef PG8_SCHED
}
}
#ifndef PG8_SP2
#define PG8_SP2 true
#endif
#ifndef PG8_ALIGN
#define PG8_ALIGN true
#endif
#ifndef MK_MULTI
#define MK_MULTI 0
#endif

constexpr int NWAVES = 8, NTHR = NWAVES * 64;
constexpr int BATCH = 2, T = 4096, D = 2048, M = BATCH * T, FF = 5632, DEPTH = 4;
constexpr int LRU_W = 1024, EVEN_IN = 3328, ODD_IN = 6160, ODD_N = 6144;
constexpr int GLA_DK = 1024, GLA_DV = 2048, GLA_HK = 256, GLA_HV = 512;
constexpr float DN_ALPHA = 1.6817928305074290f;
constexpr float LN_EPS = 1e-5f, RMS_EPS = 1e-6f;
constexpr int NSUB = 12, SLOTS = 6, NPHASE = 1 + NSUB * SLOTS;

constexpr size_t MiB = 1u << 20;
constexpr size_t WS_CTL = 0, CTL_ZERO_BYTES = 1 * MiB;
constexpr size_t WS_WGU = 1 * MiB, SZ_WGU = 44 * MiB;
constexpr size_t WS_WD = WS_WGU + 8 * SZ_WGU, SZ_WD = 22 * MiB;
constexpr size_t WS_WEIN = WS_WD + 8 * SZ_WD, SZ_WEIN = 13 * MiB;
constexpr size_t WS_WEOUT = WS_WEIN + 2 * SZ_WEIN, SZ_WOUT = 8 * MiB;
constexpr size_t WS_WOIN = WS_WEOUT + 2 * SZ_WOUT, SZ_WOIN = 24 * MiB;
constexpr size_t WS_WOOUT = WS_WOIN + 2 * SZ_WOIN;
constexpr size_t WS_X = WS_WOOUT + 2 * SZ_WOUT;
constexpr size_t WS_Y = WS_X + 64 * MiB;
constexpr size_t WS_XB = WS_Y + 64 * MiB;
constexpr size_t WS_H = WS_XB + 32 * MiB;
constexpr size_t WS_PROJ = WS_H + 88 * MiB;
constexpr size_t WS_MIX = WS_PROJ + 96 * MiB;
constexpr size_t WS_S0 = WS_MIX + 32 * MiB;
constexpr size_t WS_LRU_A = WS_S0, WS_LRU_U = WS_S0 + 32 * MiB, WS_LRU_SUM = WS_S0 + 64 * MiB;
constexpr size_t WS_GLA_ALR = WS_S0, WS_GLA_G = WS_S0 + 1 * MiB, WS_GLA_O = WS_S0 + 33 * MiB;
constexpr size_t WS_END = WS_S0 + 97 * MiB;
constexpr int CW_TMO = 0, CW_CODE = 1, CW_BAR = 4096;

constexpr int RING_OFF = 0, RING_BYTES = 131072;
constexpr int LDSCTL_OFF = RING_BYTES, MISC_OFF = LDSCTL_OFF + 320, SCR_OFF = LDSCTL_OFF + 512;
constexpr int LDS_BYTES = 147456;

#define GAS __attribute__((address_space(1)))
#define LAS __attribute__((address_space(3)))
typedef unsigned short bf16;
typedef unsigned v4u __attribute__((ext_vector_type(4)));
typedef unsigned v2u __attribute__((ext_vector_type(2)));
typedef float f32x4 __attribute__((ext_vector_type(4)));
typedef GAS unsigned gu32;
#define RLX_AGENT __ATOMIC_RELAXED, __HIP_MEMORY_SCOPE_AGENT
#define LDS_WAIT() asm volatile("s_waitcnt lgkmcnt(0)" ::: "memory")
#define VM_WAIT() asm volatile("s_waitcnt vmcnt(0)" ::: "memory")
__device__ __forceinline__ unsigned f2bf(float f) { unsigned u = __builtin_bit_cast(unsigned, f); return (u + 0x7fffu + ((u >> 16) & 1u)) >> 16; }
__device__ __forceinline__ unsigned pk2(float lo, float hi) { return f2bf(lo) | (f2bf(hi) << 16); }
__device__ __forceinline__ float bflo(unsigned w) { return __builtin_bit_cast(float, w << 16); }
__device__ __forceinline__ float bfhi(unsigned w) { return __builtin_bit_cast(float, w & 0xffff0000u); }
__device__ __forceinline__ float bf2f(bf16 b) { return __builtin_bit_cast(float, (unsigned)b << 16); }
__device__ __forceinline__ float sigmoid_f(float x) { return 1.0f / (1.0f + __expf(-x)); }

#define XB_TMO      128
#define XB_XCNT(j)  (256  + 64 * (j))
#define XB_XSUB(j)  (1280 + 64 * (j))
#define XB_XGEN(j)  (2304 + 64 * (j))
#define XB_TOP      3328
#define XB_TOPGEN   3392
#define XCD_BAR_WORDS 3456
#define XB_SPIN_CAP (1u << 18)

__device__ __forceinline__ unsigned xb_ld(unsigned* p)              { return __hip_atomic_load(p, __ATOMIC_RELAXED, __HIP_MEMORY_SCOPE_AGENT); }
__device__ __forceinline__ unsigned xb_add(unsigned* p, unsigned v) { return __hip_atomic_fetch_add(p, v, __ATOMIC_RELAXED, __HIP_MEMORY_SCOPE_AGENT); }
__device__ __forceinline__ unsigned xb_xcc_id() { return (unsigned)__builtin_amdgcn_s_getreg((3 << 11) | 20) & 0xFu; }
#define XB_SPIN(cond, bar) do { unsigned _sp = 0; while (cond) { __builtin_amdgcn_s_sleep(1); \
    if ((++_sp & 255u) == 0u) { if (xb_ld(&(bar)[XB_TMO])) break; if (_sp > XB_SPIN_CAP) { atomicAdd(&(bar)[XB_TMO], 1u); break; } } } } while (0)

struct XcdBarrier {
    unsigned* bar; unsigned x;
    volatile LAS unsigned* st;
};

__device__ __forceinline__ XcdBarrier xcd_barrier_post(unsigned* bar, volatile LAS unsigned* st) {
    XcdBarrier b; b.bar = bar; b.x = xb_xcc_id(); b.st = st;
    if (threadIdx.x == 0) (void)xb_add(&bar[XB_XCNT(b.x)], 1u);
    return b;
}
__device__ __forceinline__ void xcd_barrier_complete(unsigned* bar, unsigned x, unsigned& nloc, unsigned& nx) {
    const unsigned G = gridDim.x * gridDim.y * gridDim.z;
    unsigned sum, cnt, mine, sp = 0u;
    for (;;) {
        sum = 0u; cnt = 0u; mine = 0u;
#pragma unroll
        for (unsigned j = 0; j < 16; ++j) { const unsigned c = xb_ld(&bar[XB_XCNT(j)]); sum += c; cnt += (c > 0u) ? 1u : 0u; mine = (j == x) ? c : mine; }
        if (sum == G) break;
        __builtin_amdgcn_s_sleep(1);
        if ((++sp & 255u) == 0u) { if (xb_ld(&bar[XB_TMO])) break; if (sp > XB_SPIN_CAP) { atomicAdd(&bar[XB_TMO], 1u); break; } }
    }
    nloc = mine > 0u ? mine : 1u; nx = cnt > 0u ? cnt : 1u;
}

__device__ __forceinline__ void xcd_barrier(const XcdBarrier& b) {
    asm volatile("s_waitcnt vmcnt(0)" ::: "memory");
    __syncthreads();
    if (threadIdx.x == 0) {
        unsigned* bar = b.bar;
        __builtin_amdgcn_s_waitcnt(0);
        unsigned nloc = b.st[0], nx = b.st[1];
        if (nloc == 0u) { xcd_barrier_complete(bar, b.x, nloc, nx); b.st[0] = nloc; b.st[1] = nx; }
        const unsigned old = xb_add(&bar[XB_XSUB(b.x)], 1u);
        const unsigned gen = old / nloc;
        if (old + 1u == (gen + 1u) * nloc) {
            __builtin_amdgcn_fence(__ATOMIC_RELEASE, "agent");
            asm volatile("s_waitcnt vmcnt(0)" ::: "memory");
            const unsigned og = xb_add(&bar[XB_TOP], 1u);
            const unsigned tg = og / nx;
            if (og + 1u == (tg + 1u) * nx) xb_add(&bar[XB_TOPGEN], 1u);
            else XB_SPIN(xb_ld(&bar[XB_TOPGEN]) == tg, bar);
            __builtin_amdgcn_fence(__ATOMIC_ACQUIRE, "agent");
            xb_add(&bar[XB_XGEN(b.x)], 1u);
            asm volatile("s_waitcnt vmcnt(0)" ::: "memory");
        } else {
            XB_SPIN(xb_ld(&bar[XB_XGEN(b.x)]) == gen, bar);
            __builtin_amdgcn_fence(__ATOMIC_ACQUIRE, "agent");
            asm volatile("s_waitcnt vmcnt(0)" ::: "memory");
        }
    }
    __syncthreads();
}


struct Frame {
    LAS unsigned char* lds;
    volatile LAS unsigned* MISC;
    gu32* ctl;
    int tid, lane, wave, vcu, G;
    const float *xin, *w_gate, *w_up, *w_down, *ln_g, *ln_b, *even_w_in, *conv_w, *conv_b, *lru_wa, *lru_ba, *lru_wx, *lru_bx, *lru_lambda, *swa_sinks, *even_w_out, *rel_bias,
                *odd_w_in, *gla_w_alpha2, *gla_b_alpha, *gla_norm_g, *odd_w_out;
    float* out;
    unsigned char* ws;
};
__device__ __forceinline__ float wave_sum(float v) {
#pragma unroll
    for (int o = 1; o < 64; o <<= 1) v += __shfl_xor(v, o);
    return v;
}

__device__ __forceinline__ void transpose_item(const float* W, int ldw, int k0, int n0, bf16* WT, int K, int dst_row0, LAS float* scr, int lane) {
#pragma unroll 8
    for (int i = 0; i < 32; ++i) { const int kk = 2 * i + (lane >> 5); scr[kk * 33 + (lane & 31)] = W[(size_t)(k0 + kk) * ldw + n0 + (lane & 31)]; }
    LDS_WAIT(); asm volatile("" ::: "memory");
    const int c = lane & 7;
#pragma unroll
    for (int j = 0; j < 4; ++j) { const int n = (lane >> 3) + 8 * j; const LAS float* s = scr + (8 * c) * 33 + n;
        v4u o; o.x = pk2(s[0 * 33], s[1 * 33]); o.y = pk2(s[2 * 33], s[3 * 33]); o.z = pk2(s[4 * 33], s[5 * 33]); o.w = pk2(s[6 * 33], s[7 * 33]);
        *(GAS v4u*)(WT + (size_t)(dst_row0 + n) * K + k0 + 8 * c) = o; }
    LDS_WAIT(); asm volatile("" ::: "memory");
}
__device__ __forceinline__ void p0_prologue(Frame& F) {
    LAS float* scr = (LAS float*)(F.lds + RING_OFF + F.wave * 16384);
    const int gw = F.vcu * NWAVES + F.wave, NGW = F.G * NWAVES;
    constexpr int I_FF = (D / 64) * (FF / 32);
    constexpr int I_EIN = (D / 64) * (EVEN_IN / 32);
    constexpr int I_SQ = (D / 64) * (D / 32);
    constexpr int I_OIN = (D / 64) * (ODD_N / 32);
    constexpr int R1 = 8 * I_FF, R2 = 2 * R1, R3 = 3 * R1, R4 = R3 + 2 * I_EIN, R5 = R4 + 2 * I_SQ, R6 = R5 + 2 * I_OIN, R7 = R6 + 2 * I_SQ;
    bf16* ws16 = (bf16*)F.ws;
    for (int it = gw; it < R7; it += NGW) {
        if (it < R2) {
            const int up = it >= R1, r = it - up * R1, mi = r / I_FF, q = r % I_FF, kb = q / (FF / 32), nb = q % (FF / 32), n0 = nb * 32;
            const float* W = (up ? F.w_up : F.w_gate) + (size_t)mi * D * FF;
            transpose_item(W, FF, kb * 64, n0, (bf16*)(F.ws + WS_WGU + (size_t)mi * SZ_WGU), D, 256 * (n0 >> 7) + (n0 & 127) + up * 128, scr, F.lane);
        } else if (it < R3) {
            const int r = it - R2, mi = r / I_FF, q = r % I_FF, kb = q / (D / 32), nb = q % (D / 32);
            transpose_item(F.w_down + (size_t)mi * FF * D, D, kb * 64, nb * 32, (bf16*)(F.ws + WS_WD + (size_t)mi * SZ_WD), FF, nb * 32, scr, F.lane);
        } else if (it < R4) {
            const int r = it - R3, mi = r / I_EIN, q = r % I_EIN, kb = q / (EVEN_IN / 32), nb = q % (EVEN_IN / 32);
            transpose_item(F.even_w_in + (size_t)mi * D * EVEN_IN, EVEN_IN, kb * 64, nb * 32, (bf16*)(F.ws + WS_WEIN + (size_t)mi * SZ_WEIN), D, nb * 32, scr, F.lane);
        } else if (it < R5) {
            const int r = it - R4, mi = r / I_SQ, q = r % I_SQ, kb = q / (D / 32), nb = q % (D / 32);
            transpose_item(F.even_w_out + (size_t)mi * D * D, D, kb * 64, nb * 32, (bf16*)(F.ws + WS_WEOUT + (size_t)mi * SZ_WOUT), D, nb * 32, scr, F.lane);
        } else if (it < R6) {
            const int r = it - R5, mi = r / I_OIN, q = r % I_OIN, kb = q / (ODD_N / 32), nb = q % (ODD_N / 32);
            transpose_item(F.odd_w_in + (size_t)mi * D * ODD_IN, ODD_IN, kb * 64, nb * 32, (bf16*)(F.ws + WS_WOIN + (size_t)mi * SZ_WOIN), D, nb * 32, scr, F.lane);
        } else {
            const int r = it - R6, mi = r / I_SQ, q = r % I_SQ, kb = q / (D / 32), nb = q % (D / 32);
            transpose_item(F.odd_w_out + (size_t)mi * D * D, D, kb * 64, nb * 32, (bf16*)(F.ws + WS_WOOUT + (size_t)mi * SZ_WOUT), D, nb * 32, scr, F.lane);
        }
    }
    (void)ws16;
    bf16* XB = (bf16*)(F.ws + WS_XB);
    for (int m = gw; m < M; m += NGW) {
        const GAS f32x4* xr = (const GAS f32x4*)(F.xin + (size_t)m * D) + F.lane;
        GAS v2u* o8 = (GAS v2u*)(XB + (size_t)m * D) + F.lane;
#pragma unroll
        for (int j = 0; j < 8; ++j) { const f32x4 v = xr[64 * j]; v2u o; o.x = pk2(v.x, v.y); o.y = pk2(v.z, v.w); o8[64 * j] = o; }
    }
}

__device__ __forceinline__ void ln_phase(Frame& F, const float* Y, const float* g, const float* b, float* Xout, bf16* XB) {
    const int gw = F.vcu * NWAVES + F.wave, NGW = F.G * NWAVES;
    for (int m = gw; m < M; m += NGW) {
        const GAS f32x4* yr = (const GAS f32x4*)(Y + (size_t)m * D) + F.lane;
        f32x4 v[8]; float s = 0.f;
#pragma unroll
        for (int j = 0; j < 8; ++j) { v[j] = yr[64 * j]; s += (v[j].x + v[j].y) + (v[j].z + v[j].w); }
        const float mean = wave_sum(s) * (1.f / D); float s2 = 0.f;
#pragma unroll
        for (int j = 0; j < 8; ++j) { v[j] = v[j] - mean; s2 += (v[j].x * v[j].x + v[j].y * v[j].y) + (v[j].z * v[j].z + v[j].w * v[j].w); }
        const float rstd = 1.f / sqrtf(wave_sum(s2) * (1.f / D) + LN_EPS);
        GAS f32x4* xo = (GAS f32x4*)(Xout + (size_t)m * D) + F.lane;
        GAS v2u* o8 = (GAS v2u*)(XB + (size_t)m * D) + F.lane;
        const GAS f32x4* gp = (const GAS f32x4*)g + F.lane; const GAS f32x4* bp = (const GAS f32x4*)b + F.lane;
#pragma unroll
        for (int j = 0; j < 8; ++j) { const f32x4 o = v[j] * rstd * gp[64 * j] + bp[64 * j]; xo[64 * j] = o; v2u w; w.x = pk2(o.x, o.y); w.y = pk2(o.z, o.w); o8[64 * j] = w; }
    }
}

__device__ __forceinline__ void lru_local_phase(Frame& F, int j) {
    LAS float* xin = (LAS float*)(F.lds + RING_OFF);
    LAS float* xc = xin + 67 * 64;
    LAS float* wa = xc + 64 * 65;
    LAS float* wx = wa + 4096;
    LAS float* sa = wx + 4096;
    LAS float* su = sa + 4096;
    const bf16* PROJ = (const bf16*)(F.ws + WS_PROJ);
    float* Abuf = (float*)(F.ws + WS_LRU_A); float* Ubuf = (float*)(F.ws + WS_LRU_U); float* SUM = (float*)(F.ws + WS_LRU_SUM);
    const float* cw = F.conv_w + (size_t)j * 4 * LRU_W; const float* cb = F.conv_b + (size_t)j * LRU_W;
    const float* ba = F.lru_ba + (size_t)j * LRU_W; const float* bx = F.lru_bx + (size_t)j * LRU_W; const float* lam = F.lru_lambda + (size_t)j * LRU_W;
    const int tid = F.tid;
    for (int unit = blockIdx.x; unit < 2048; unit += F.G) {
        const int hh = unit & 15, c = (unit >> 4) & 63, b = unit >> 10, t0 = c * 64; const size_t mrow0 = (size_t)b * T + t0;
        for (int idx = tid; idx < 67 * 64; idx += NTHR) { const int r = idx >> 6, ch = idx & 63, t = t0 - 3 + r;
            xin[idx] = t >= 0 ? bf2f(PROJ[((size_t)b * T + t) * EVEN_IN + hh * 64 + ch]) : 0.f; }
        const float* gwa = F.lru_wa + ((size_t)j * 16 + hh) * 4096; const float* gwx = F.lru_wx + ((size_t)j * 16 + hh) * 4096;
        for (int idx = tid; idx < 4096; idx += NTHR) { wa[idx] = gwa[idx]; wx[idx] = gwx[idx]; }
        __syncthreads();
        for (int idx = tid; idx < 4096; idx += NTHR) { const int t = idx >> 6, ch = idx & 63, gch = hh * 64 + ch; float acc = cb[gch];
#pragma unroll
            for (int jj = 0; jj < 4; ++jj) acc += cw[jj * LRU_W + gch] * xin[(t + jj) * 64 + ch];
            xc[t * 65 + ch] = acc; }
        __syncthreads();
        {
            const int ch = tid & 63, tg = tid >> 6, gch = hh * 64 + ch;
            float ra[8], rx[8];
#pragma unroll
            for (int tt = 0; tt < 8; ++tt) { ra[tt] = 0.f; rx[tt] = 0.f; }
            for (int i = 0; i < 64; ++i) { const float wai = wa[i * 64 + ch], wxi = wx[i * 64 + ch];
#pragma unroll
                for (int tt = 0; tt < 8; ++tt) { const float xv = xc[(tg * 8 + tt) * 65 + i]; ra[tt] += xv * wai; rx[tt] += xv * wxi; } }
            const float sp = log1pf(expf(-lam[gch])), bav = ba[gch], bxv = bx[gch];
#pragma unroll
            for (int tt = 0; tt < 8; ++tt) { const int t = tg * 8 + tt;
                const float r = sigmoid_f(ra[tt] + bav), ig = sigmoid_f(rx[tt] + bxv), la = -8.0f * r * sp, a = expf(la), uu = sqrtf(-expm1f(2.0f * la)) * (ig * xc[t * 65 + ch]);
                sa[t * 64 + ch] = a; su[t * 64 + ch] = uu; Abuf[(mrow0 + t) * LRU_W + gch] = a; Ubuf[(mrow0 + t) * LRU_W + gch] = uu; }
        }
        __syncthreads();
        if (tid < 64) { float h = 0.f, P = 1.f;
            for (int t = 0; t < 64; ++t) { const float a = sa[t * 64 + tid]; h = a * h + su[t * 64 + tid]; P *= a; }
            float* sp2 = SUM + (((size_t)b * 64 + c) * LRU_W + hh * 64 + tid) * 2; sp2[0] = P; sp2[1] = h; }
        __syncthreads();
    }
}
__device__ __forceinline__ float gelu_tanh(float x) { const float u = 0.7978845608028654f * (x + 0.044715f * x * x * x); return 0.5f * x * (1.0f + tanhf(u)); }
__device__ __forceinline__ void lru_fix_phase(Frame& F) {
    const bf16* PROJ = (const bf16*)(F.ws + WS_PROJ); bf16* MIX = (bf16*)(F.ws + WS_MIX);
    const float* Abuf = (const float*)(F.ws + WS_LRU_A); const float* Ubuf = (const float*)(F.ws + WS_LRU_U); const float* SUM = (const float*)(F.ws + WS_LRU_SUM);
    for (int unit = blockIdx.x; unit < 256; unit += F.G) {
        const int half = unit & 1, c = (unit >> 1) & 63, b = unit >> 7, ch = half * 512 + F.tid;
        float h = 0.f;
        for (int cc = 0; cc < c; ++cc) { const float* sp2 = SUM + (((size_t)b * 64 + cc) * LRU_W + ch) * 2; h = sp2[0] * h + sp2[1]; }
        const size_t m0 = (size_t)b * T + c * 64;
        for (int t = 0; t < 64; ++t) { const size_t m = m0 + t; h = Abuf[m * LRU_W + ch] * h + Ubuf[m * LRU_W + ch];
            const float ga = bf2f(PROJ[m * EVEN_IN + LRU_W + ch]);
            MIX[m * D + ch] = (bf16)f2bf(gelu_tanh(ga) * h); }
    }
}
__device__ __forceinline__ void swa_phase(Frame& F, int j) {
    LAS float* Ks = (LAS float*)(F.lds + RING_OFF);
    LAS float* Vs = Ks + 256 * 64;
    LAS float* btab = (LAS float*)(F.lds + SCR_OFF);
    const bf16* PROJ = (const bf16*)(F.ws + WS_PROJ); bf16* MIX = (bf16*)(F.ws + WS_MIX);
    const int tid = F.tid, lane = F.lane, w = F.wave;
    for (int unit = blockIdx.x; unit < 256; unit += F.G) {
        const int half = unit & 1, kvh = (unit >> 1) & 1, nb = (unit >> 2) & 31, b = unit >> 7, hq = kvh * 8 + w;
        __syncthreads();
        for (int idx = tid; idx < 8 * 128; idx += NTHR) { const int hh = idx >> 7, d = idx & 127;
            int bucket = d; if (d >= 16) { bucket = 16 + (int)(logf((float)d * (1.0f / 16.0f)) / 2.0794415416798357f * 16.0f); bucket = bucket > 31 ? 31 : bucket; }
            btab[idx] = F.rel_bias[bucket * 16 + kvh * 8 + hh]; }
        for (int idx = tid; idx < 2048; idx += NTHR) { const int r = idx >> 3, c8 = idx & 7, kabs = nb * 128 + r - 128;
            v4u kk = (v4u){0u, 0u, 0u, 0u}, vv = (v4u){0u, 0u, 0u, 0u};
            if (kabs >= 0) { const bf16* rowp = PROJ + ((size_t)b * T + kabs) * EVEN_IN; kk = *(const GAS v4u*)(rowp + 3072 + kvh * 64 + c8 * 8); vv = *(const GAS v4u*)(rowp + 3200 + kvh * 64 + c8 * 8); }
            LAS float* kd = Ks + r * 64 + c8 * 8; LAS float* vd = Vs + r * 64 + c8 * 8;
            kd[0] = bflo(kk.x); kd[1] = bfhi(kk.x); kd[2] = bflo(kk.y); kd[3] = bfhi(kk.y); kd[4] = bflo(kk.z); kd[5] = bfhi(kk.z); kd[6] = bflo(kk.w); kd[7] = bfhi(kk.w);
            vd[0] = bflo(vv.x); vd[1] = bfhi(vv.x); vd[2] = bflo(vv.y); vd[3] = bfhi(vv.y); vd[4] = bflo(vv.z); vd[5] = bfhi(vv.z); vd[6] = bflo(vv.w); vd[7] = bfhi(vv.w); }
        __syncthreads();
        const int i = half * 64 + lane; const size_t m = (size_t)b * T + nb * 128 + i;
        float q[64], o[64];
        { const bf16* qp = PROJ + m * EVEN_IN + 2048 + hq * 64;
#pragma unroll
          for (int c8 = 0; c8 < 8; ++c8) { const v4u t = *(const GAS v4u*)(qp + c8 * 8);
              q[c8 * 8 + 0] = bflo(t.x) * 0.125f; q[c8 * 8 + 1] = bfhi(t.x) * 0.125f; q[c8 * 8 + 2] = bflo(t.y) * 0.125f; q[c8 * 8 + 3] = bfhi(t.y) * 0.125f;
              q[c8 * 8 + 4] = bflo(t.z) * 0.125f; q[c8 * 8 + 5] = bfhi(t.z) * 0.125f; q[c8 * 8 + 6] = bflo(t.w) * 0.125f; q[c8 * 8 + 7] = bfhi(t.w) * 0.125f; } }
#pragma unroll
        for (int d = 0; d < 64; ++d) o[d] = 0.f;
        float mx = F.swa_sinks[j * 16 + hq], l = 1.0f;
        const LAS float* bt = btab + w * 128;
        const int jlo = half * 64 + 1, jhi = half * 64 + 63 + 128;
        for (int jk = jlo; jk <= jhi; ++jk) {
            const LAS f32x4* kr = (const LAS f32x4*)(Ks + jk * 64); float s = 0.f;
#pragma unroll
            for (int c4 = 0; c4 < 16; ++c4) { const f32x4 kv = kr[c4]; s += q[c4 * 4] * kv.x + q[c4 * 4 + 1] * kv.y + q[c4 * 4 + 2] * kv.z + q[c4 * 4 + 3] * kv.w; }
            const int dist = i + 128 - jk; const bool ok = (dist >= 0) && (dist < 128) && (nb * 128 + jk - 128 >= 0);
            s = ok ? s + bt[dist & 127] : -__builtin_inff();
            const float mn = fmaxf(mx, s), sc = __expf(mx - mn), pe = __expf(s - mn);
            l = l * sc + pe; mx = mn;
            const LAS f32x4* vr = (const LAS f32x4*)(Vs + jk * 64);
#pragma unroll
            for (int c4 = 0; c4 < 16; ++c4) { const f32x4 vv = vr[c4]; o[c4 * 4] = o[c4 * 4] * sc + pe * vv.x; o[c4 * 4 + 1] = o[c4 * 4 + 1] * sc + pe * vv.y; o[c4 * 4 + 2] = o[c4 * 4 + 2] * sc + pe * vv.z; o[c4 * 4 + 3] = o[c4 * 4 + 3] * sc + pe * vv.w; }
        }
        const float inv = 1.0f / l;
        bf16* op = MIX + m * D + LRU_W + hq * 64;
#pragma unroll
        for (int c8 = 0; c8 < 8; ++c8) { v4u t; t.x = pk2(o[c8 * 8] * inv, o[c8 * 8 + 1] * inv); t.y = pk2(o[c8 * 8 + 2] * inv, o[c8 * 8 + 3] * inv); t.z = pk2(o[c8 * 8 + 4] * inv, o[c8 * 8 + 5] * inv); t.w = pk2(o[c8 * 8 + 6] * inv, o[c8 * 8 + 7] * inv);
            *(GAS v4u*)(op + c8 * 8) = t; }
    }
    __syncthreads();
}

__device__ __forceinline__ void gla_gate_phase(Frame& F, int j) {
    LAS float* alr = (LAS float*)(F.lds + RING_OFF);
    const float* X = (const float*)(F.ws + WS_X); float* G = (float*)(F.ws + WS_GLA_G);
    const float* W = F.odd_w_in + (size_t)j * D * ODD_IN + ODD_N;
    const float* w2 = F.gla_w_alpha2 + (size_t)j * 16 * GLA_DK; const float* bal = F.gla_b_alpha + (size_t)j * GLA_DK;
    const int tid = F.tid;
    for (int unit = blockIdx.x; unit < M / 32; unit += F.G) {
        __syncthreads();
        { const int r = tid & 15, row = tid >> 4; const float* xr = X + (size_t)(unit * 32 + row) * D; float acc = 0.f;
          for (int k = 0; k < D; k += 4) { const f32x4 xv = *(const GAS f32x4*)(xr + k);
              acc += xv.x * W[(size_t)k * ODD_IN + r] + xv.y * W[(size_t)(k + 1) * ODD_IN + r] + xv.z * W[(size_t)(k + 2) * ODD_IN + r] + xv.w * W[(size_t)(k + 3) * ODD_IN + r]; }
          alr[row * 16 + r] = acc; }
        __syncthreads();
#pragma unroll
        for (int jj = 0; jj < 2; ++jj) { const int d = tid + jj * NTHR; float wc[16];
#pragma unroll
            for (int r = 0; r < 16; ++r) wc[r] = w2[r * GLA_DK + d];
            const float bb = bal[d];
            for (int row = 0; row < 32; ++row) { float lg = bb;
#pragma unroll
                for (int r = 0; r < 16; ++r) lg += alr[row * 16 + r] * wc[r];
                const float ls = fminf(lg, 0.f) - log1pf(expf(-fabsf(lg)));
                G[(size_t)(unit * 32 + row) * GLA_DK + d] = expf(ls * (1.0f / 16.0f)); } }
    }
    __syncthreads();
}
__device__ __forceinline__ void gla_scan_phase(Frame& F) {
    LAS float* red = (LAS float*)(F.lds + RING_OFF);
    const bf16* PROJ = (const bf16*)(F.ws + WS_PROJ); const float* G = (const float*)(F.ws + WS_GLA_G); float* O = (float*)(F.ws + WS_GLA_O);
    const int tid = F.tid, lane = F.lane, w = F.wave, e = tid & 15, d0 = (tid >> 4) * 8;
    for (int unit = blockIdx.x; unit < 256; unit += F.G) {
        const int es = unit & 31, h = (unit >> 5) & 3, b = unit >> 7, e0 = es * 16;
        float S[8];
#pragma unroll
        for (int i = 0; i < 8; ++i) S[i] = 0.f;
        for (int tb = 0; tb < T; tb += 8) {
            f32x4 g0[8], g1[8]; v4u kk[8], qq[8]; float vv[8];
#pragma unroll
            for (int tt = 0; tt < 8; ++tt) { const size_t m = (size_t)b * T + tb + tt; const bf16* rowp = PROJ + m * ODD_N;
                g0[tt] = *(const GAS f32x4*)(G + m * GLA_DK + h * 256 + d0); g1[tt] = *(const GAS f32x4*)(G + m * GLA_DK + h * 256 + d0 + 4);
                qq[tt] = *(const GAS v4u*)(rowp + h * 256 + d0); kk[tt] = *(const GAS v4u*)(rowp + 1024 + h * 256 + d0); vv[tt] = bf2f(rowp[2048 + h * 512 + e0 + e]); }
            __syncthreads();
#pragma unroll
            for (int tt = 0; tt < 8; ++tt) {
                const float v = vv[tt]; float part;
                S[0] = g0[tt].x * S[0] + bflo(kk[tt].x) * v; part = bflo(qq[tt].x) * S[0];
                S[1] = g0[tt].y * S[1] + bfhi(kk[tt].x) * v; part += bfhi(qq[tt].x) * S[1];
                S[2] = g0[tt].z * S[2] + bflo(kk[tt].y) * v; part += bflo(qq[tt].y) * S[2];
                S[3] = g0[tt].w * S[3] + bfhi(kk[tt].y) * v; part += bfhi(qq[tt].y) * S[3];
                S[4] = g1[tt].x * S[4] + bflo(kk[tt].z) * v; part += bflo(qq[tt].z) * S[4];
                S[5] = g1[tt].y * S[5] + bfhi(kk[tt].z) * v; part += bfhi(qq[tt].z) * S[5];
                S[6] = g1[tt].z * S[6] + bflo(kk[tt].w) * v; part += bflo(qq[tt].w) * S[6];
                S[7] = g1[tt].w * S[7] + bfhi(kk[tt].w) * v; part += bfhi(qq[tt].w) * S[7];
                part += __shfl_xor(part, 16); part += __shfl_xor(part, 32);
                if (lane < 16) red[(tt * 8 + w) * 16 + lane] = part;
            }
            __syncthreads();
            if (tid < 128) { const int tt = tid >> 4, ee = tid & 15; float s = 0.f;
#pragma unroll
                for (int ww = 0; ww < 8; ++ww) s += red[(tt * 8 + ww) * 16 + ee];
                O[((size_t)b * T + tb + tt) * GLA_DV + h * 512 + e0 + ee] = s * (1.0f / 16.0f); }
        }
    }
    __syncthreads();
}
__device__ __forceinline__ void gla_post_phase(Frame& F, int j) {
    const bf16* PROJ = (const bf16*)(F.ws + WS_PROJ); const float* O = (const float*)(F.ws + WS_GLA_O); bf16* MIX = (bf16*)(F.ws + WS_MIX);
    const float* ng = F.gla_norm_g + (size_t)j * GLA_HV;
    const int gw = F.vcu * NWAVES + F.wave, NGW = F.G * NWAVES, lane = F.lane;
    const f32x4 n0 = *(const GAS f32x4*)(ng + lane * 8), n1 = *(const GAS f32x4*)(ng + lane * 8 + 4);
    for (int it = gw; it < M * 4; it += NGW) { const int h = it & 3; const size_t m = it >> 2;
        const f32x4 a = *(const GAS f32x4*)(O + m * GLA_DV + h * 512 + lane * 8), c = *(const GAS f32x4*)(O + m * GLA_DV + h * 512 + lane * 8 + 4);
        const v4u rr = *(const GAS v4u*)(PROJ + m * ODD_N + 4096 + h * 512 + lane * 8);
        const float ss = wave_sum((a.x * a.x + a.y * a.y) + (a.z * a.z + a.w * a.w) + (c.x * c.x + c.y * c.y) + (c.z * c.z + c.w * c.w));
        const float rs = 1.0f / sqrtf(ss * (1.0f / 512.0f) + RMS_EPS);
        float r[8] = {bflo(rr.x), bfhi(rr.x), bflo(rr.y), bfhi(rr.y), bflo(rr.z), bfhi(rr.z), bflo(rr.w), bfhi(rr.w)};
        float ov[8] = {a.x * rs * n0.x, a.y * rs * n0.y, a.z * rs * n0.z, a.w * rs * n0.w, c.x * rs * n1.x, c.y * rs * n1.y, c.z * rs * n1.z, c.w * rs * n1.w};
        float y[8];
#pragma unroll
        for (int i = 0; i < 8; ++i) y[i] = ov[i] * (r[i] * sigmoid_f(r[i]));
        v4u t; t.x = pk2(y[0], y[1]); t.y = pk2(y[2], y[3]); t.z = pk2(y[4], y[5]); t.w = pk2(y[6], y[7]);
        *(GAS v4u*)(MIX + m * D + h * 512 + lane * 8) = t; }
}

__host__ __device__ inline bool phase_active(int p) {
    if (p == 0) return true;
    const int s = (p - 1) / SLOTS, k = (p - 1) % SLOTS, l = s / 3, kind = s % 3;
    if (k == 0 || k == 4 || k == 5) return true;
    if (kind != 1) return false;
    if ((l & 1) == 0) return k == 1 || k == 2;
    return true;
}
struct Args { const float* in[22]; float* out; unsigned char* ws; int ph_lo, ph_hi; };
__global__ void __launch_bounds__(NTHR, 2) mk_fwd(Args args) {
    extern __shared__ __attribute__((aligned(16))) unsigned char lds[];
    Frame F;
    F.lds = (LAS unsigned char*)lds;
    F.MISC = (volatile LAS unsigned*)(F.lds + MISC_OFF);
    F.tid = threadIdx.x; F.lane = F.tid & 63; F.wave = __builtin_amdgcn_readfirstlane(F.tid >> 6);
    F.G = gridDim.x; { const int bx = blockIdx.x; F.vcu = (F.G % 8 == 0) ? (bx % 8) * (F.G / 8) + bx / 8 : bx; }
    F.ws = args.ws; F.ctl = (gu32*)(args.ws + WS_CTL); F.out = args.out;
    F.xin = args.in[0]; F.w_gate = args.in[1]; F.w_up = args.in[2]; F.w_down = args.in[3]; F.ln_g = args.in[4]; F.ln_b = args.in[5]; F.even_w_in = args.in[6]; F.conv_w = args.in[7]; F.conv_b = args.in[8];
    F.lru_wa = args.in[9]; F.lru_ba = args.in[10]; F.lru_wx = args.in[11]; F.lru_bx = args.in[12]; F.lru_lambda = args.in[13]; F.swa_sinks = args.in[14]; F.even_w_out = args.in[15]; F.rel_bias = args.in[16];
    F.odd_w_in = args.in[17]; F.gla_w_alpha2 = args.in[18]; F.gla_b_alpha = args.in[19]; F.gla_norm_g = args.in[20]; F.odd_w_out = args.in[21];
    for (int u = F.tid; u < (LDS_BYTES - LDSCTL_OFF) / 4; u += NTHR) ((LAS unsigned*)(F.lds + LDSCTL_OFF))[u] = 0u;
    __syncthreads();
#if MK_MULTI
#define GRID_BAR() do { } while (0)
#else
    XcdBarrier bar = xcd_barrier_post((unsigned*)(F.ctl + CW_BAR), F.MISC + 8);
#define GRID_BAR() xcd_barrier(bar)
#endif
    const int lo = args.ph_lo, hi = args.ph_hi;
#define IN(k) (lo <= (k) && (k) < hi)
#define REFRESH() do { int t_ = threadIdx.x; asm volatile("" : "+v"(t_)); F.tid = t_; F.lane = t_ & 63; F.wave = __builtin_amdgcn_readfirstlane(t_ >> 6); unsigned char* w_ = args.ws; asm volatile("" : "+s"(w_)); F.ws = w_; } while (0)
#define SEAM(k) do { if ((k) + 1 < hi) GRID_BAR(); } while (0)
#define X ((float*)(F.ws + WS_X))
#define Y ((float*)(F.ws + WS_Y))
#define XB ((bf16*)(F.ws + WS_XB))
#define H ((bf16*)(F.ws + WS_H))
#define PROJ ((bf16*)(F.ws + WS_PROJ))
#define MIX ((bf16*)(F.ws + WS_MIX))

    if (IN(0)) { REFRESH(); p0_prologue(F); SEAM(0); }

    for (int s = 0; s < NSUB; ++s) {
        const int l = s / 3, kind = s % 3, j = l >> 1, pb = 1 + s * SLOTS, odd = l & 1;
        const int fi = l * 2 + (kind == 2 ? 1 : 0);
        if (IN(pb + 0)) {
            REFRESH();
            if (kind != 1) {
                pg8::Gemm g{XB, (const bf16*)(F.ws + WS_WGU + (size_t)fi * SZ_WGU), M, 2 * FF, D}; pg8::StaticOrder S; S.init(M, 2 * FF, F.G, (int)blockIdx.x);
                pg8::EpiSwiGLU E{H, FF};
                pg8::gemm_phase<pg8::EpiSwiGLU, pg8::StaticOrder, PG8_ALIGN, PG8_SP2>(F.lds + RING_OFF, g, S, E);
            } else {
                const int N = odd ? ODD_N : EVEN_IN;
                const bf16* Wt = odd ? (const bf16*)(F.ws + WS_WOIN + (size_t)j * SZ_WOIN) : (const bf16*)(F.ws + WS_WEIN + (size_t)j * SZ_WEIN);
                pg8::Gemm g{XB, Wt, M, N, D}; pg8::StaticOrder S; S.init(M, N, F.G, (int)blockIdx.x);
                pg8::EpiPlainBf16 E{PROJ, N};
                pg8::gemm_phase<pg8::EpiPlainBf16, pg8::StaticOrder, PG8_ALIGN, PG8_SP2>(F.lds + RING_OFF, g, S, E);
            }
            SEAM(pb + 0);
        }
        if (kind == 1) {
            if (!odd) {
                if (IN(pb + 1)) { REFRESH(); lru_local_phase(F, j); REFRESH(); swa_phase(F, j); SEAM(pb + 1); }
                if (IN(pb + 2)) { REFRESH(); lru_fix_phase(F); SEAM(pb + 2); }
            } else {
                if (IN(pb + 1)) { REFRESH(); gla_gate_phase(F, j); SEAM(pb + 1); }
                if (IN(pb + 2)) { REFRESH(); gla_scan_phase(F); SEAM(pb + 2); }
                if (IN(pb + 3)) { REFRESH(); gla_post_phase(F, j); SEAM(pb + 3); }
            }
        }
        if (IN(pb + 4)) {
            REFRESH();
            const bf16* A = kind != 1 ? H : MIX; const int K = kind != 1 ? FF : D;
            const bf16* Wt = kind != 1 ? (const bf16*)(F.ws + WS_WD + (size_t)fi * SZ_WD) : (odd ? (const bf16*)(F.ws + WS_WOOUT + (size_t)j * SZ_WOUT) : (const bf16*)(F.ws + WS_WEOUT + (size_t)j * SZ_WOUT));
            pg8::Gemm g{A, Wt, M, D, K}; pg8::StaticOrder S; S.init(M, D, F.G, (int)blockIdx.x);
            pg8::EpiResid E{s == 0 ? F.xin : X, Y, D, DN_ALPHA, kind != 1 ? 0.5f : 1.0f};
            pg8::gemm_phase<pg8::EpiResid, pg8::StaticOrder, PG8_ALIGN, PG8_SP2>(F.lds + RING_OFF, g, S, E);
            SEAM(pb + 4);
        }
        if (IN(pb + 5)) {
            REFRESH();
            ln_phase(F, Y, F.ln_g + (size_t)(l * 3 + kind) * D, F.ln_b + (size_t)(l * 3 + kind) * D, s == NSUB - 1 ? F.out : X, XB);
            SEAM(pb + 5);
        }
    }
#undef IN
#undef SEAM
#undef X
#undef Y
#undef XB
#undef H
#undef PROJ
#undef MIX
}

extern "C" void kernel_launch(void* const* d_in, const int* in_sizes, int n_in, void* d_out, int out_size, void* d_ws, size_t ws_size, hipStream_t stream) {
    static int grid = 0;
    if (grid == 0) {
        if (n_in != 22 || in_sizes[0] != M * D || out_size != M * D || ws_size < WS_END) { fprintf(stderr, "kernel_launch: unexpected shapes (n_in %d, in0 %d, out %d, ws %zu < %zu); nothing launched\n", n_in, n_in > 0 ? in_sizes[0] : -1, out_size, ws_size, (size_t)WS_END); grid = -1; return; }
        int dev = 0, cus = 0, per_cu = 0;
        if (hipGetDevice(&dev) != hipSuccess || hipDeviceGetAttribute(&cus, hipDeviceAttributeMultiprocessorCount, dev) != hipSuccess) { grid = -1; return; }
        if (hipFuncSetAttribute((const void*)mk_fwd, hipFuncAttributeMaxDynamicSharedMemorySize, LDS_BYTES) != hipSuccess) { fprintf(stderr, "kernel_launch: hipFuncSetAttribute failed\n"); grid = -1; return; }
        if (hipOccupancyMaxActiveBlocksPerMultiprocessor(&per_cu, (const void*)mk_fwd, NTHR, LDS_BYTES) != hipSuccess || per_cu < 1) { fprintf(stderr, "kernel_launch: occupancy query says %d blocks per CU\n", per_cu); }
        (void)hipGetLastError();
        grid = cus;
    }
    if (grid < 0) return;
    (void)hipMemsetAsync((char*)d_ws + WS_CTL, 0, CTL_ZERO_BYTES, stream);
    Args a{};
    for (int i = 0; i < 22; ++i) a.in[i] = (const float*)d_in[i];
    a.out = (float*)d_out; a.ws = (unsigned char*)d_ws;
#if MK_MULTI
    for (int p = 0; p < NPHASE; ++p) { if (!phase_active(p)) continue; a.ph_lo = p; a.ph_hi = p + 1; hipLaunchKernelGGL(mk_fwd, dim3(grid), dim3(NTHR), LDS_BYTES, stream, a); }
#else
    a.ph_lo = 0; a.ph_hi = NPHASE; hipLaunchKernelGGL(mk_fwd, dim3(grid), dim3(NTHR), LDS_BYTES, stream, a);
#endif
    const hipError_t le = hipPeekAtLastError();
    if (le != hipSuccess) fprintf(stderr, "kernel_launch: launch failed: %s\n", hipGetErrorName(le));
}
```

```cpp
#include <hip/hip_runtime.h>
#include <cstdio>
#include <cstdint>
namespace pg8 {
#define PG8_LAS __attribute__((address_space(3)))
typedef unsigned short bf16_t;
typedef short bf16x8 __attribute__((ext_vector_type(8)));
typedef float f32x4 __attribute__((ext_vector_type(4)));
typedef unsigned u32x4 __attribute__((ext_vector_type(4)));
constexpr int BM = 256, BK = 64, HALF = 128, HTB = HALF * BK * 2  , STAGE_BYTES = 8 * HTB, NXCD = 8, WGM = 8;

__host__ __device__ __forceinline__ int lds_byte(int r, int c) { const int st = (r >> 4) * 2 + (c >> 5), rr = r & 15, cc = c & 31, ob = rr * 64 + cc * 2; return st * 1024 + (ob ^ (((ob >> 9) & 1) << 5)); }
__host__ __device__ __forceinline__ void stage_rc(int b, int& R, int& C) { const int st = b / 1024, sb = b % 1024, swz = sb ^ (((sb >> 9) & 1) << 5); R = (st >> 1) * 16 + swz / 64; C = (st & 1) * 32 + (swz % 64) / 2; }
__host__ __device__ __forceinline__ int perm32(int rho) { const int n = rho >> 4, i = rho & 15; return 8 * (i >> 2) + 4 * n + (i & 3); }

struct Unit { int pm, pn; };
struct Gemm { const bf16_t* A; const bf16_t* Bt; int M, N, K; };

struct StaticOrder {
    int nM, nN, nwg, G, c;
    __host__ __device__ void init(int M, int N, int G_, int c_) { nM = M / BM; nN = N / BM; nwg = nM * nN; G = G_; c = c_; }
    __host__ __device__ bool next(int i, Unit& u) const {
        const long L = (long)i * G + c; if (L >= nwg) return false;
        int wgid = (int)L; { const int q = nwg / NXCD, r = nwg % NXCD, xcd = wgid % NXCD, off = wgid / NXCD; wgid = (xcd < r ? xcd * (q + 1) : r * (q + 1) + (xcd - r) * q) + off; }
        const int nig = WGM * nN, gid = wgid / nig, fm = gid * WGM, gsz = (nM - fm) < WGM ? (nM - fm) : WGM;
        u.pm = fm + ((wgid % nig) % gsz); u.pn = (wgid % nig) / gsz; return true;
    }
    __device__ __forceinline__ void a_ready(const Unit&) const {}
    __device__ __forceinline__ void done(const Unit&) const {}
};

__device__ __forceinline__ unsigned cvt_pk_bf16(float lo, float hi) { unsigned r; asm volatile("v_cvt_pk_bf16_f32 %0, %1, %2" : "=v"(r) : "v"(lo), "v"(hi)); return r; }
typedef float f32x2 __attribute__((ext_vector_type(2)));
__device__ __forceinline__ float silu_f(float g) { return g * __builtin_amdgcn_rcpf(1.0f + __expf(-g)); }
struct EpiPlainBf16 {
    static constexpr bool PERM = true, AFTER_DRAIN = false;
    bf16_t* O; int ldc;
    __device__ __forceinline__ void operator()(const f32x4 (&acc)[2][2][4][2], const Unit& u, int wr, int wc, int fr, int fq) const {
        const int row0 = u.pm * BM + wr * 64 + fr, col0 = u.pn * BM + wc * 32 + 8 * fq;
#pragma unroll
        for (int ai = 0; ai < 2; ++ai)
#pragma unroll
            for (int m = 0; m < 4; ++m) { bf16_t* rowp = O + (size_t)(row0 + ai * HALF + m * 16) * ldc + col0;
#pragma unroll
                for (int bj = 0; bj < 2; ++bj) { const f32x4 v0 = acc[ai][bj][m][0], v1 = acc[ai][bj][m][1];
                    u32x4 w; w.x = cvt_pk_bf16(v0[0], v0[1]); w.y = cvt_pk_bf16(v0[2], v0[3]); w.z = cvt_pk_bf16(v1[0], v1[1]); w.w = cvt_pk_bf16(v1[2], v1[3]);
                    *(u32x4*)(rowp + bj * HALF) = w; } }
    }
};
struct EpiSwiGLU {
    static constexpr bool PERM = true, AFTER_DRAIN = false;
    bf16_t* O; int ldc;
    __device__ __forceinline__ void operator()(const f32x4 (&acc)[2][2][4][2], const Unit& u, int wr, int wc, int fr, int fq) const {
        const int row0 = u.pm * BM + wr * 64 + fr, col0 = u.pn * HALF + wc * 32 + 8 * fq;
#pragma unroll
        for (int ai = 0; ai < 2; ++ai)
#pragma unroll
            for (int m = 0; m < 4; ++m) { bf16_t* rowp = O + (size_t)(row0 + ai * HALF + m * 16) * ldc + col0;
                const f32x4 g0 = acc[ai][0][m][0], g1 = acc[ai][0][m][1], u0 = acc[ai][1][m][0], u1 = acc[ai][1][m][1];
                u32x4 w;
                w.x = cvt_pk_bf16(silu_f(g0[0]) * u0[0], silu_f(g0[1]) * u0[1]); w.y = cvt_pk_bf16(silu_f(g0[2]) * u0[2], silu_f(g0[3]) * u0[3]);
                w.z = cvt_pk_bf16(silu_f(g1[0]) * u1[0], silu_f(g1[1]) * u1[1]); w.w = cvt_pk_bf16(silu_f(g1[2]) * u1[2], silu_f(g1[3]) * u1[3]);
                *(u32x4*)rowp = w; }
    }
};
struct EpiResid {
    static constexpr bool PERM = false, AFTER_DRAIN = false;
    const float* R; float* Y; int ldc; float alpha, beta;
    __device__ __forceinline__ void operator()(const f32x4 (&acc)[2][2][4][2], const Unit& u, int wr, int wc, int fr, int fq) const {
        const int row0 = u.pm * BM + wr * 64 + fr, col0 = u.pn * BM + wc * 32 + 4 * fq;
#pragma unroll
        for (int ai = 0; ai < 2; ++ai)
#pragma unroll
            for (int m = 0; m < 4; ++m) { const size_t off = (size_t)(row0 + ai * HALF + m * 16) * ldc + col0;
#pragma unroll
                for (int bj = 0; bj < 2; ++bj)
#pragma unroll
                    for (int n = 0; n < 2; ++n) { const f32x4 r = *(const f32x4*)(R + off + bj * HALF + n * 16);
                        *(f32x4*)(Y + off + bj * HALF + n * 16) = r * alpha + acc[ai][bj][m][n] * beta; }
                asm volatile("" ::: "memory"); }
    }
};

template <class Epi, class Sched, bool ALIGN_EPI = false, bool SP2 = false>
__device__ __forceinline__ void gemm_phase(PG8_LAS unsigned char* lds, const Gemm g, const Sched& S, const Epi& E) {
    int tid_ = threadIdx.x; asm volatile("" : "+v"(tid_));
    const int tid = tid_, wid = __builtin_amdgcn_readfirstlane(tid >> 6), lane = tid & 63, wr = wid >> 2, wc = wid & 3, fr = lane & 15, fq = lane >> 4;
    const int K = g.K, nt = K / BK;
    unsigned voffA[2], voffB[2];
#pragma unroll
    for (int i = 0; i < 2; ++i) { int R, C; stage_rc(tid * 16 + i * 8192, R, C); const int Rb = Epi::PERM ? ((R & ~31) + perm32(R & 31)) : R;
        voffA[i] = (unsigned)(R * K + C) * 2u; voffB[i] = (unsigned)(Rb * K + C) * 2u; }
    const size_t kstep = (size_t)(BK * 2);
    const size_t hstep = (size_t)HALF * K * 2;
    const size_t tstep = 2 * hstep;
    const unsigned ldsw = (unsigned)wid * 1024u;
    const int aoff = lds_byte(wr * 64 + fr, fq * 8), boff = lds_byte(wc * 32 + fr, fq * 8);
#define PG8_SA(b, h) (((b) * 2 + (h)) * HTB)
#define PG8_SB(b, h) ((4 + (b) * 2 + (h)) * HTB)
#define PG8_STAGE(bufoff, gbase, voff) do { _Pragma("unroll") for (int _i = 0; _i < 2; ++_i) \
        __builtin_amdgcn_global_load_lds((const unsigned*)((const char*)(gbase) + (voff)[_i]), (PG8_LAS unsigned*)(lds + (bufoff) + ldsw + _i * 8192), 16, 0, 0); } while (0)
#define PG8_LDA(dst, b, h) do { _Pragma("unroll") for (int m = 0; m < 4; ++m) _Pragma("unroll") for (int k = 0; k < 2; ++k) dst[m][k] = *(const PG8_LAS bf16x8*)(lds + PG8_SA(b, h) + aoff + m * 2048 + k * 1024); } while (0)
#define PG8_LDB(dst, b, h) do { _Pragma("unroll") for (int n = 0; n < 2; ++n) _Pragma("unroll") for (int k = 0; k < 2; ++k) dst[n][k] = *(const PG8_LAS bf16x8*)(lds + PG8_SB(b, h) + boff + n * 2048 + k * 1024); } while (0)
#define PG8_MMA(ai, bj, At, Bt) do { __builtin_amdgcn_s_setprio(1); _Pragma("unroll") for (int m = 0; m < 4; ++m) _Pragma("unroll") for (int n = 0; n < 2; ++n) _Pragma("unroll") for (int k = 0; k < 2; ++k) \
        acc[ai][bj][m][n] = __builtin_amdgcn_mfma_f32_16x16x32_bf16(Bt[n][k], At[m][k], acc[ai][bj][m][n], 0, 0, 0); __builtin_amdgcn_s_setprio(0); } while (0)
#define PG8_WAIT_V(n) asm volatile("s_waitcnt vmcnt(" #n ")" ::: "memory")
#define PG8_WAIT_L(n) asm volatile("s_waitcnt lgkmcnt(" #n ")" ::: "memory")
#define PG8_BAR __builtin_amdgcn_s_barrier()
#define PG8_SCHED __builtin_amdgcn_sched_barrier(0)
    Unit cur, nxt; int ui = 0;
    if (!S.next(0, cur)) return;
    f32x4 acc[2][2][4][2];
#pragma unroll
    for (int a = 0; a < 2; ++a)
#pragma unroll
        for (int b = 0; b < 2; ++b)
#pragma unroll
            for (int m = 0; m < 4; ++m)
#pragma unroll
                for (int n = 0; n < 2; ++n) acc[a][b][m][n] = (f32x4){0.f, 0.f, 0.f, 0.f};
    bf16x8 At[4][2], B0[2][2], B1[2][2];
    const char* cA = (const char*)g.A + (size_t)cur.pm * tstep; const char* cB = (const char*)g.Bt + (size_t)cur.pn * tstep;
    S.a_ready(cur);
    if constexpr (SP2) {
        PG8_STAGE(PG8_SB(0, 0), cB, voffB); PG8_STAGE(PG8_SB(0, 1), cB + hstep, voffB); PG8_STAGE(PG8_SA(0, 0), cA, voffA); PG8_STAGE(PG8_SA(0, 1), cA + hstep, voffA);
        if (wr == 1) PG8_BAR;
        PG8_WAIT_V(2); PG8_BAR;
        PG8_STAGE(PG8_SB(1, 0), cB + kstep, voffB); PG8_STAGE(PG8_SA(1, 0), cA + kstep, voffA); PG8_STAGE(PG8_SB(1, 1), cB + hstep + kstep, voffB);
        PG8_WAIT_V(6); PG8_BAR;
    } else {
        PG8_STAGE(PG8_SB(0, 0), cB, voffB); PG8_STAGE(PG8_SA(0, 0), cA, voffA); PG8_STAGE(PG8_SB(0, 1), cB + hstep, voffB); PG8_STAGE(PG8_SA(0, 1), cA + hstep, voffA);
        if (wr == 1) PG8_BAR;
        PG8_WAIT_V(4); PG8_BAR;
        PG8_STAGE(PG8_SB(1, 0), cB + kstep, voffB); PG8_STAGE(PG8_SA(1, 0), cA + kstep, voffA); PG8_STAGE(PG8_SB(1, 1), cB + hstep + kstep, voffB);
        PG8_WAIT_V(6); PG8_BAR;
    }
    for (;;) {
        const bool has_next = S.next(ui + 1, nxt);
        const char* nA = has_next ? (const char*)g.A + (size_t)nxt.pm * tstep : cA; const char* nB = has_next ? (const char*)g.Bt + (size_t)nxt.pn * tstep : cB;
        for (int t = 0; t < nt; t += 2) {
            const bool last = (t == nt - 2);
            const char* a1 = cA + (size_t)(t + 1) * kstep;
            const char* a2 = last ? nA : cA + (size_t)(t + 2) * kstep; const char* b2 = last ? nB : cB + (size_t)(t + 2) * kstep;
            const char* a3 = a2 + kstep; const char* b3 = b2 + kstep;
            if (last && has_next) S.a_ready(nxt);
            if constexpr (SP2) {
            PG8_LDB(B0, 0, 0); PG8_LDB(B1, 0, 1); PG8_SCHED; PG8_LDA(At, 0, 0); PG8_STAGE(PG8_SA(1, 1), a1 + hstep, voffA);
            PG8_WAIT_V(8); PG8_WAIT_L(0); PG8_BAR; PG8_MMA(0, 0, At, B0); PG8_MMA(0, 1, At, B1); PG8_BAR; PG8_SCHED;
            PG8_LDA(At, 0, 1); PG8_STAGE(PG8_SB(0, 0), b2, voffB); PG8_STAGE(PG8_SB(0, 1), b2 + hstep, voffB); PG8_STAGE(PG8_SA(0, 0), a2, voffA);
            PG8_WAIT_V(8); PG8_WAIT_L(0); PG8_BAR; PG8_MMA(1, 0, At, B0); PG8_MMA(1, 1, At, B1); PG8_BAR; PG8_SCHED;
            PG8_LDB(B0, 1, 0); PG8_LDB(B1, 1, 1); PG8_SCHED; PG8_LDA(At, 1, 0); PG8_STAGE(PG8_SA(0, 1), a2 + hstep, voffA);
            PG8_WAIT_V(8); PG8_WAIT_L(0); PG8_BAR; PG8_MMA(0, 0, At, B0); PG8_MMA(0, 1, At, B1); PG8_BAR; PG8_SCHED;
            PG8_LDA(At, 1, 1); PG8_STAGE(PG8_SB(1, 0), b3, voffB); PG8_STAGE(PG8_SB(1, 1), b3 + hstep, voffB); PG8_STAGE(PG8_SA(1, 0), a3, voffA);
            PG8_WAIT_V(8); PG8_WAIT_L(0); PG8_BAR; PG8_MMA(1, 0, At, B0); PG8_MMA(1, 1, At, B1); PG8_BAR; PG8_SCHED;
            } else {
            PG8_LDB(B0, 0, 0); PG8_SCHED; PG8_LDA(At, 0, 0); PG8_STAGE(PG8_SA(1, 1), a1 + hstep, voffA);
            PG8_WAIT_L(8); PG8_BAR; PG8_WAIT_L(0); PG8_MMA(0, 0, At, B0); PG8_BAR; PG8_SCHED;
            PG8_LDB(B1, 0, 1); PG8_STAGE(PG8_SB(0, 0), b2, voffB);
            PG8_BAR; PG8_WAIT_L(0); PG8_MMA(0, 1, At, B1); PG8_BAR;
            PG8_LDA(At, 0, 1); PG8_STAGE(PG8_SA(0, 0), a2, voffA);
            PG8_BAR; PG8_WAIT_L(0); PG8_MMA(1, 0, At, B0); PG8_BAR; PG8_SCHED;
            PG8_STAGE(PG8_SB(0, 1), b2 + hstep, voffB);
            PG8_WAIT_V(6); PG8_BAR; PG8_MMA(1, 1, At, B1); PG8_BAR;
            PG8_LDB(B0, 1, 0); PG8_SCHED; PG8_LDA(At, 1, 0); PG8_STAGE(PG8_SA(0, 1), a2 + hstep, voffA);
            PG8_WAIT_L(8); PG8_BAR; PG8_WAIT_L(0); PG8_MMA(0, 0, At, B0); PG8_BAR; PG8_SCHED;
            PG8_LDB(B1, 1, 1); PG8_STAGE(PG8_SB(1, 0), b3, voffB);
            PG8_BAR; PG8_WAIT_L(0); PG8_MMA(0, 1, At, B1); PG8_BAR;
            PG8_LDA(At, 1, 1); PG8_STAGE(PG8_SA(1, 0), a3, voffA);
            PG8_BAR; PG8_WAIT_L(0); PG8_MMA(1, 0, At, B0); PG8_BAR; PG8_SCHED;
            PG8_STAGE(PG8_SB(1, 1), b3 + hstep, voffB);
            PG8_WAIT_V(6); PG8_BAR; PG8_MMA(1, 1, At, B1); PG8_BAR;
            }
        }
        if constexpr (ALIGN_EPI) { if (wr == 0) PG8_BAR; }
        if constexpr (!Epi::AFTER_DRAIN) { E(acc, cur, wr, wc, fr, fq); S.done(cur); }
        if (!has_next) break;
#pragma unroll
        for (int a = 0; a < 2; ++a)
#pragma unroll
            for (int b = 0; b < 2; ++b)
#pragma unroll
                for (int m = 0; m < 4; ++m)
#pragma unroll
                    for (int n = 0; n < 2; ++n) acc[a][b][m][n] = (f32x4){0.f, 0.f, 0.f, 0.f};
        cur = nxt; cA = nA; cB = nB; ++ui;
        if constexpr (ALIGN_EPI) { if (wr == 1) PG8_BAR; }
    }
    PG8_WAIT_V(0);
    if constexpr (!ALIGN_EPI) { if (wr == 0) PG8_BAR; }
    PG8_BAR;
    if constexpr (Epi::AFTER_DRAIN) { E.fused(acc, cur, wr, wc, fr, fq, lds, wid, lane); S.done(cur); }
#undef PG8_SA
#undef PG8_SB
#undef PG8_STAGE
#undef PG8_LDA
#undef PG8_LDB
#undef PG8_MMA
#undef PG8_WAIT_V
#undef PG8_WAIT_L
#undef PG8_BAR
#undef PG8_SCHED
}
}
#ifndef PG8_SP2
#define PG8_SP2 true
#endif
#ifndef PG8_ALIGN
#define PG8_ALIGN true
#endif
#ifndef REP_IN
#define REP_IN 1
#endif
#ifndef REP_OUT
#define REP_OUT 1
#endif
#ifndef REP_LN
#define REP_LN 1
#endif
#ifndef REP_P0
#define REP_P0 1
#endif
#ifndef MK_MULTI
#define MK_MULTI 0
#endif

constexpr int NWAVES = 8, NTHR = NWAVES * 64;
constexpr int BATCH = 2, T = 4096, D = 2048, M = BATCH * T, FF = 5632, DEPTH = 4;
constexpr int LRU_W = 1024, EVEN_IN = 3328, ODD_IN = 6160, ODD_N = 6144;
constexpr int GLA_DK = 1024, GLA_DV = 2048, GLA_HK = 256, GLA_HV = 512;
constexpr float DN_ALPHA = 1.6817928305074290f;
constexpr float LN_EPS = 1e-5f, RMS_EPS = 1e-6f;
constexpr int NSUB = 12, SLOTS = 6, NPHASE = 1 + NSUB * SLOTS;

constexpr size_t MiB = 1u << 20;
constexpr size_t WS_CTL = 0, CTL_ZERO_BYTES = 1 * MiB;
constexpr size_t WS_WGU = 1 * MiB, SZ_WGU = 44 * MiB;
constexpr size_t WS_WD = WS_WGU + 8 * SZ_WGU, SZ_WD = 22 * MiB;
constexpr size_t WS_WEIN = WS_WD + 8 * SZ_WD, SZ_WEIN = 13 * MiB;
constexpr size_t WS_WEOUT = WS_WEIN + 2 * SZ_WEIN, SZ_WOUT = 8 * MiB;
constexpr size_t WS_WOIN = WS_WEOUT + 2 * SZ_WOUT, SZ_WOIN = 24 * MiB;
constexpr size_t WS_WOOUT = WS_WOIN + 2 * SZ_WOIN;
constexpr size_t WS_X = WS_WOOUT + 2 * SZ_WOUT;
constexpr size_t WS_Y = WS_X + 64 * MiB;
constexpr size_t WS_XB = WS_Y + 64 * MiB;
constexpr size_t WS_H = WS_XB + 32 * MiB;
constexpr size_t WS_PROJ = WS_H + 88 * MiB;
constexpr size_t WS_MIX = WS_PROJ + 96 * MiB;
constexpr size_t WS_S0 = WS_MIX + 32 * MiB;
constexpr size_t WS_LRU_A = WS_S0, WS_LRU_U = WS_S0 + 32 * MiB, WS_LRU_SUM = WS_S0 + 64 * MiB;
constexpr size_t WS_GLA_ALR = WS_S0, WS_GLA_G = WS_S0 + 1 * MiB, WS_GLA_O = WS_S0 + 33 * MiB;
constexpr size_t WS_GLA_QT = WS_S0 + 97 * MiB, WS_GLA_KT = WS_GLA_QT + 16 * MiB, WS_GLA_VT = WS_GLA_KT + 16 * MiB, WS_GLA_AI = WS_GLA_VT + 32 * MiB, WS_GLA_GAM = WS_GLA_AI + 4 * MiB;
constexpr size_t WS_WALR = WS_GLA_GAM + 1 * MiB;
constexpr size_t WS_END = WS_WALR + 1 * MiB;
constexpr int CW_TMO = 0, CW_CODE = 1, CW_BAR = 4096;

constexpr int RING_OFF = 0, RING_BYTES = 131072;
constexpr int LDSCTL_OFF = RING_BYTES, MISC_OFF = LDSCTL_OFF + 320, SCR_OFF = LDSCTL_OFF + 512;
constexpr int LDS_BYTES = 147456;

#define GAS __attribute__((address_space(1)))
#define LAS __attribute__((address_space(3)))
typedef unsigned short bf16;
typedef unsigned v4u __attribute__((ext_vector_type(4)));
typedef unsigned v2u __attribute__((ext_vector_type(2)));
typedef float f32x4 __attribute__((ext_vector_type(4)));
typedef GAS unsigned gu32;
#define RLX_AGENT __ATOMIC_RELAXED, __HIP_MEMORY_SCOPE_AGENT
#define LDS_WAIT() asm volatile("s_waitcnt lgkmcnt(0)" ::: "memory")
#define VM_WAIT() asm volatile("s_waitcnt vmcnt(0)" ::: "memory")
__device__ __forceinline__ unsigned f2bf(float f) { unsigned u = __builtin_bit_cast(unsigned, f); return (u + 0x7fffu + ((u >> 16) & 1u)) >> 16; }
__device__ __forceinline__ unsigned pk2(float lo, float hi) { return f2bf(lo) | (f2bf(hi) << 16); }
__device__ __forceinline__ float bflo(unsigned w) { return __builtin_bit_cast(float, w << 16); }
__device__ __forceinline__ float bfhi(unsigned w) { return __builtin_bit_cast(float, w & 0xffff0000u); }
__device__ __forceinline__ float bf2f(bf16 b) { return __builtin_bit_cast(float, (unsigned)b << 16); }
__device__ __forceinline__ float sigmoid_f(float x) { return 1.0f / (1.0f + __expf(-x)); }

#define XB_TMO      128
#define XB_XCNT(j)  (256  + 64 * (j))
#define XB_XSUB(j)  (1280 + 64 * (j))
#define XB_XGEN(j)  (2304 + 64 * (j))
#define XB_TOP      3328
#define XB_TOPGEN   3392
#define XCD_BAR_WORDS 3456
#define XB_SPIN_CAP (1u << 18)

__device__ __forceinline__ unsigned xb_ld(unsigned* p)              { return __hip_atomic_load(p, __ATOMIC_RELAXED, __HIP_MEMORY_SCOPE_AGENT); }
__device__ __forceinline__ unsigned xb_add(unsigned* p, unsigned v) { return __hip_atomic_fetch_add(p, v, __ATOMIC_RELAXED, __HIP_MEMORY_SCOPE_AGENT); }
__device__ __forceinline__ unsigned xb_xcc_id() { return (unsigned)__builtin_amdgcn_s_getreg((3 << 11) | 20) & 0xFu; }
#define XB_SPIN(cond, bar) do { unsigned _sp = 0; while (cond) { __builtin_amdgcn_s_sleep(1); \
    if ((++_sp & 255u) == 0u) { if (xb_ld(&(bar)[XB_TMO])) break; if (_sp > XB_SPIN_CAP) { atomicAdd(&(bar)[XB_TMO], 1u); break; } } } } while (0)

struct XcdBarrier {
    unsigned* bar; unsigned x;
    volatile LAS unsigned* st;
};

__device__ __forceinline__ XcdBarrier xcd_barrier_post(unsigned* bar, volatile LAS unsigned* st) {
    XcdBarrier b; b.bar = bar; b.x = xb_xcc_id(); b.st = st;
    if (threadIdx.x == 0) (void)xb_add(&bar[XB_XCNT(b.x)], 1u);
    return b;
}
__device__ __forceinline__ void xcd_barrier_complete(unsigned* bar, unsigned x, unsigned& nloc, unsigned& nx) {
    const unsigned G = gridDim.x * gridDim.y * gridDim.z;
    unsigned sum, cnt, mine, sp = 0u;
    for (;;) {
        sum = 0u; cnt = 0u; mine = 0u;
#pragma unroll
        for (unsigned j = 0; j < 16; ++j) { const unsigned c = xb_ld(&bar[XB_XCNT(j)]); sum += c; cnt += (c > 0u) ? 1u : 0u; mine = (j == x) ? c : mine; }
        if (sum == G) break;
        __builtin_amdgcn_s_sleep(1);
        if ((++sp & 255u) == 0u) { if (xb_ld(&bar[XB_TMO])) break; if (sp > XB_SPIN_CAP) { atomicAdd(&bar[XB_TMO], 1u); break; } }
    }
    nloc = mine > 0u ? mine : 1u; nx = cnt > 0u ? cnt : 1u;
}

__device__ __forceinline__ void xcd_barrier(const XcdBarrier& b) {
    asm volatile("s_waitcnt vmcnt(0)" ::: "memory");
    __syncthreads();
    if (threadIdx.x == 0) {
        unsigned* bar = b.bar;
        __builtin_amdgcn_s_waitcnt(0);
        unsigned nloc = b.st[0], nx = b.st[1];
        if (nloc == 0u) { xcd_barrier_complete(bar, b.x, nloc, nx); b.st[0] = nloc; b.st[1] = nx; }
        const unsigned old = xb_add(&bar[XB_XSUB(b.x)], 1u);
        const unsigned gen = old / nloc;
        if (old + 1u == (gen + 1u) * nloc) {
            __builtin_amdgcn_fence(__ATOMIC_RELEASE, "agent");
            asm volatile("s_waitcnt vmcnt(0)" ::: "memory");
            const unsigned og = xb_add(&bar[XB_TOP], 1u);
            const unsigned tg = og / nx;
            if (og + 1u == (tg + 1u) * nx) xb_add(&bar[XB_TOPGEN], 1u);
            else XB_SPIN(xb_ld(&bar[XB_TOPGEN]) == tg, bar);
            __builtin_amdgcn_fence(__ATOMIC_ACQUIRE, "agent");
            xb_add(&bar[XB_XGEN(b.x)], 1u);
            asm volatile("s_waitcnt vmcnt(0)" ::: "memory");
        } else {
            XB_SPIN(xb_ld(&bar[XB_XGEN(b.x)]) == gen, bar);
            __builtin_amdgcn_fence(__ATOMIC_ACQUIRE, "agent");
            asm volatile("s_waitcnt vmcnt(0)" ::: "memory");
        }
    }
    __syncthreads();
}


struct Frame {
    LAS unsigned char* lds;
    volatile LAS unsigned* MISC;
    gu32* ctl;
    int tid, lane, wave, vcu, G;
    const float *xin, *w_gate, *w_up, *w_down, *ln_g, *ln_b, *even_w_in, *conv_w, *conv_b, *lru_wa, *lru_ba, *lru_wx, *lru_bx, *lru_lambda, *swa_sinks, *even_w_out, *rel_bias,
                *odd_w_in, *gla_w_alpha2, *gla_b_alpha, *gla_norm_g, *odd_w_out;
    float* out;
    unsigned char* ws;
};
__device__ __forceinline__ float wave_sum(float v) {
#pragma unroll
    for (int o = 1; o < 64; o <<= 1) v += __shfl_xor(v, o);
    return v;
}

__device__ __forceinline__ void transpose_item(const float* W, int ldw, int k0, int n0, bf16* WT, int K, int dst_row0, LAS float* scr, int lane) {
#pragma unroll 8
    for (int i = 0; i < 32; ++i) { const int kk = 2 * i + (lane >> 5); scr[kk * 33 + (lane & 31)] = W[(size_t)(k0 + kk) * ldw + n0 + (lane & 31)]; }
    LDS_WAIT(); asm volatile("" ::: "memory");
    const int c = lane & 7;
#pragma unroll
    for (int j = 0; j < 4; ++j) { const int n = (lane >> 3) + 8 * j; const LAS float* s = scr + (8 * c) * 33 + n;
        v4u o; o.x = pk2(s[0 * 33], s[1 * 33]); o.y = pk2(s[2 * 33], s[3 * 33]); o.z = pk2(s[4 * 33], s[5 * 33]); o.w = pk2(s[6 * 33], s[7 * 33]);
        *(GAS v4u*)(WT + (size_t)(dst_row0 + n) * K + k0 + 8 * c) = o; }
    LDS_WAIT(); asm volatile("" ::: "memory");
}
__device__ __forceinline__ void p0_prologue(Frame& F) {
    LAS float* scr = (LAS float*)(F.lds + RING_OFF + F.wave * 16384);
    const int gw = F.vcu * NWAVES + F.wave, NGW = F.G * NWAVES;
    constexpr int I_FF = (D / 64) * (FF / 32);
    constexpr int I_EIN = (D / 64) * (EVEN_IN / 32);
    constexpr int I_SQ = (D / 64) * (D / 32);
    constexpr int I_OIN = (D / 64) * (ODD_N / 32);
    constexpr int R1 = 8 * I_FF, R2 = 2 * R1, R3 = 3 * R1, R4 = R3 + 2 * I_EIN, R5 = R4 + 2 * I_SQ, R6 = R5 + 2 * I_OIN, R7 = R6 + 2 * I_SQ;
    bf16* ws16 = (bf16*)F.ws;
    for (int it = gw; it < R7; it += NGW) {
        if (it < R2) {
            const int up = it >= R1, r = it - up * R1, mi = r / I_FF, q = r % I_FF, kb = q / (FF / 32), nb = q % (FF / 32), n0 = nb * 32;
            const float* W = (up ? F.w_up : F.w_gate) + (size_t)mi * D * FF;
            transpose_item(W, FF, kb * 64, n0, (bf16*)(F.ws + WS_WGU + (size_t)mi * SZ_WGU), D, 256 * (n0 >> 7) + (n0 & 127) + up * 128, scr, F.lane);
        } else if (it < R3) {
            const int r = it - R2, mi = r / I_FF, q = r % I_FF, kb = q / (D / 32), nb = q % (D / 32);
            transpose_item(F.w_down + (size_t)mi * FF * D, D, kb * 64, nb * 32, (bf16*)(F.ws + WS_WD + (size_t)mi * SZ_WD), FF, nb * 32, scr, F.lane);
        } else if (it < R4) {
            const int r = it - R3, mi = r / I_EIN, q = r % I_EIN, kb = q / (EVEN_IN / 32), nb = q % (EVEN_IN / 32);
            transpose_item(F.even_w_in + (size_t)mi * D * EVEN_IN, EVEN_IN, kb * 64, nb * 32, (bf16*)(F.ws + WS_WEIN + (size_t)mi * SZ_WEIN), D, nb * 32, scr, F.lane);
        } else if (it < R5) {
            const int r = it - R4, mi = r / I_SQ, q = r % I_SQ, kb = q / (D / 32), nb = q % (D / 32);
            transpose_item(F.even_w_out + (size_t)mi * D * D, D, kb * 64, nb * 32, (bf16*)(F.ws + WS_WEOUT + (size_t)mi * SZ_WOUT), D, nb * 32, scr, F.lane);
        } else if (it < R6) {
            const int r = it - R5, mi = r / I_OIN, q = r % I_OIN, kb = q / (ODD_N / 32), nb = q % (ODD_N / 32);
            transpose_item(F.odd_w_in + (size_t)mi * D * ODD_IN, ODD_IN, kb * 64, nb * 32, (bf16*)(F.ws + WS_WOIN + (size_t)mi * SZ_WOIN), D, nb * 32, scr, F.lane);
        } else {
            const int r = it - R6, mi = r / I_SQ, q = r % I_SQ, kb = q / (D / 32), nb = q % (D / 32);
            transpose_item(F.odd_w_out + (size_t)mi * D * D, D, kb * 64, nb * 32, (bf16*)(F.ws + WS_WOOUT + (size_t)mi * SZ_WOUT), D, nb * 32, scr, F.lane);
        }
    }
    (void)ws16;
    { bf16* WALR = (bf16*)(F.ws + WS_WALR);
      for (int idx = gw * 64 + F.lane; idx < 2 * D * 16; idx += NGW * 64) { const int n = idx & 15, k = (idx >> 4) & (D - 1), jj = idx >> 15;
          WALR[((size_t)jj * 16 + n) * D + k] = (bf16)f2bf(F.odd_w_in[((size_t)jj * D + k) * ODD_IN + ODD_N + n]); } }
    bf16* XB = (bf16*)(F.ws + WS_XB);
    for (int m = gw; m < M; m += NGW) {
        const GAS f32x4* xr = (const GAS f32x4*)(F.xin + (size_t)m * D) + F.lane;
        GAS v2u* o8 = (GAS v2u*)(XB + (size_t)m * D) + F.lane;
#pragma unroll
        for (int j = 0; j < 8; ++j) { const f32x4 v = xr[64 * j]; v2u o; o.x = pk2(v.x, v.y); o.y = pk2(v.z, v.w); o8[64 * j] = o; }
    }
}

__device__ __forceinline__ void ln_phase(Frame& F, const float* Y, const float* g, const float* b, float* Xout, bf16* XB) {
    const int gw = F.vcu * NWAVES + F.wave, NGW = F.G * NWAVES;
    for (int m = gw; m < M; m += NGW) {
        const GAS f32x4* yr = (const GAS f32x4*)(Y + (size_t)m * D) + F.lane;
        f32x4 v[8]; float s = 0.f;
#pragma unroll
        for (int j = 0; j < 8; ++j) { v[j] = yr[64 * j]; s += (v[j].x + v[j].y) + (v[j].z + v[j].w); }
        const float mean = wave_sum(s) * (1.f / D); float s2 = 0.f;
#pragma unroll
        for (int j = 0; j < 8; ++j) { v[j] = v[j] - mean; s2 += (v[j].x * v[j].x + v[j].y * v[j].y) + (v[j].z * v[j].z + v[j].w * v[j].w); }
        const float rstd = 1.f / sqrtf(wave_sum(s2) * (1.f / D) + LN_EPS);
        GAS f32x4* xo = (GAS f32x4*)(Xout + (size_t)m * D) + F.lane;
        GAS v2u* o8 = (GAS v2u*)(XB + (size_t)m * D) + F.lane;
        const GAS f32x4* gp = (const GAS f32x4*)g + F.lane; const GAS f32x4* bp = (const GAS f32x4*)b + F.lane;
#pragma unroll
        for (int j = 0; j < 8; ++j) { const f32x4 o = v[j] * rstd * gp[64 * j] + bp[64 * j]; xo[64 * j] = o; v2u w; w.x = pk2(o.x, o.y); w.y = pk2(o.z, o.w); o8[64 * j] = w; }
    }
}

__device__ __forceinline__ void lru_local_phase(Frame& F, int j) {
    LAS float* xin = (LAS float*)(F.lds + RING_OFF);
    LAS float* xc = xin + 67 * 64;
    LAS float* wa = xc + 64 * 65;
    LAS float* wx = wa + 4096;
    LAS float* sa = wx + 4096;
    LAS float* su = sa + 4096;
    const bf16* PROJ = (const bf16*)(F.ws + WS_PROJ);
    float* Abuf = (float*)(F.ws + WS_LRU_A); float* Ubuf = (float*)(F.ws + WS_LRU_U); float* SUM = (float*)(F.ws + WS_LRU_SUM);
    const float* cw = F.conv_w + (size_t)j * 4 * LRU_W; const float* cb = F.conv_b + (size_t)j * LRU_W;
    const float* ba = F.lru_ba + (size_t)j * LRU_W; const float* bx = F.lru_bx + (size_t)j * LRU_W; const float* lam = F.lru_lambda + (size_t)j * LRU_W;
    const int tid = F.tid;
    for (int unit = blockIdx.x; unit < 2048; unit += F.G) {
        const int hh = unit & 15, c = (unit >> 4) & 63, b = unit >> 10, t0 = c * 64; const size_t mrow0 = (size_t)b * T + t0;
        for (int idx = tid; idx < 67 * 64; idx += NTHR) { const int r = idx >> 6, ch = idx & 63, t = t0 - 3 + r;
            xin[idx] = t >= 0 ? bf2f(PROJ[((size_t)b * T + t) * EVEN_IN + hh * 64 + ch]) : 0.f; }
        const float* gwa = F.lru_wa + ((size_t)j * 16 + hh) * 4096; const float* gwx = F.lru_wx + ((size_t)j * 16 + hh) * 4096;
        for (int idx = tid; idx < 4096; idx += NTHR) { wa[idx] = gwa[idx]; wx[idx] = gwx[idx]; }
        __syncthreads();
        for (int idx = tid; idx < 4096; idx += NTHR) { const int t = idx >> 6, ch = idx & 63, gch = hh * 64 + ch; float acc = cb[gch];
#pragma unroll
            for (int jj = 0; jj < 4; ++jj) acc += cw[jj * LRU_W + gch] * xin[(t + jj) * 64 + ch];
            xc[t * 65 + ch] = acc; }
        __syncthreads();
        {
            const int ch = tid & 63, tg = tid >> 6, gch = hh * 64 + ch;
            float ra[8], rx[8];
#pragma unroll
            for (int tt = 0; tt < 8; ++tt) { ra[tt] = 0.f; rx[tt] = 0.f; }
            for (int i = 0; i < 64; ++i) { const float wai = wa[i * 64 + ch], wxi = wx[i * 64 + ch];
#pragma unroll
                for (int tt = 0; tt < 8; ++tt) { const float xv = xc[(tg * 8 + tt) * 65 + i]; ra[tt] += xv * wai; rx[tt] += xv * wxi; } }
            const float sp = log1pf(expf(-lam[gch])), bav = ba[gch], bxv = bx[gch];
#pragma unroll
            for (int tt = 0; tt < 8; ++tt) { const int t = tg * 8 + tt;
                const float r = sigmoid_f(ra[tt] + bav), ig = sigmoid_f(rx[tt] + bxv), la = -8.0f * r * sp, a = expf(la), uu = sqrtf(-expm1f(2.0f * la)) * (ig * xc[t * 65 + ch]);
                sa[t * 64 + ch] = a; su[t * 64 + ch] = uu; Abuf[(mrow0 + t) * LRU_W + gch] = a; Ubuf[(mrow0 + t) * LRU_W + gch] = uu; }
        }
        __syncthreads();
        if (tid < 64) { float h = 0.f, P = 1.f;
            for (int t = 0; t < 64; ++t) { const float a = sa[t * 64 + tid]; h = a * h + su[t * 64 + tid]; P *= a; }
            float* sp2 = SUM + (((size_t)b * 64 + c) * LRU_W + hh * 64 + tid) * 2; sp2[0] = P; sp2[1] = h; }
        __syncthreads();
    }
}
__device__ __forceinline__ float gelu_tanh(float x) { const float u = 0.7978845608028654f * (x + 0.044715f * x * x * x); return 0.5f * x * (1.0f + tanhf(u)); }
__device__ __forceinline__ void lru_fix_phase(Frame& F) {
    const bf16* PROJ = (const bf16*)(F.ws + WS_PROJ); bf16* MIX = (bf16*)(F.ws + WS_MIX);
    const float* Abuf = (const float*)(F.ws + WS_LRU_A); const float* Ubuf = (const float*)(F.ws + WS_LRU_U); const float* SUM = (const float*)(F.ws + WS_LRU_SUM);
    for (int unit = blockIdx.x; unit < 256; unit += F.G) {
        const int half = unit & 1, c = (unit >> 1) & 63, b = unit >> 7, ch = half * 512 + F.tid;
        float h = 0.f;
        for (int cc = 0; cc < c; ++cc) { const float* sp2 = SUM + (((size_t)b * 64 + cc) * LRU_W + ch) * 2; h = sp2[0] * h + sp2[1]; }
        const size_t m0 = (size_t)b * T + c * 64;
        for (int t = 0; t < 64; ++t) { const size_t m = m0 + t; h = Abuf[m * LRU_W + ch] * h + Ubuf[m * LRU_W + ch];
            const float ga = bf2f(PROJ[m * EVEN_IN + LRU_W + ch]);
            MIX[m * D + ch] = (bf16)f2bf(gelu_tanh(ga) * h); }
    }
}
__device__ __forceinline__ void swa_phase(Frame& F, int j) {
    LAS float* Ks = (LAS float*)(F.lds + RING_OFF);
    LAS float* Vs = Ks + 256 * 64;
    LAS float* btab = (LAS float*)(F.lds + SCR_OFF);
    const bf16* PROJ = (const bf16*)(F.ws + WS_PROJ); bf16* MIX = (bf16*)(F.ws + WS_MIX);
    const int tid = F.tid, lane = F.lane, w = F.wave;
    for (int unit = blockIdx.x; unit < 256; unit += F.G) {
        const int half = unit & 1, kvh = (unit >> 1) & 1, nb = (unit >> 2) & 31, b = unit >> 7, hq = kvh * 8 + w;
        __syncthreads();
        for (int idx = tid; idx < 8 * 128; idx += NTHR) { const int hh = idx >> 7, d = idx & 127;
            int bucket = d; if (d >= 16) { bucket = 16 + (int)(logf((float)d * (1.0f / 16.0f)) / 2.0794415416798357f * 16.0f); bucket = bucket > 31 ? 31 : bucket; }
            btab[idx] = F.rel_bias[bucket * 16 + kvh * 8 + hh]; }
        for (int idx = tid; idx < 2048; idx += NTHR) { const int r = idx >> 3, c8 = idx & 7, kabs = nb * 128 + r - 128;
            v4u kk = (v4u){0u, 0u, 0u, 0u}, vv = (v4u){0u, 0u, 0u, 0u};
            if (kabs >= 0) { const bf16* rowp = PROJ + ((size_t)b * T + kabs) * EVEN_IN; kk = *(const GAS v4u*)(rowp + 3072 + kvh * 64 + c8 * 8); vv = *(const GAS v4u*)(rowp + 3200 + kvh * 64 + c8 * 8); }
            LAS float* kd = Ks + r * 64 + c8 * 8; LAS float* vd = Vs + r * 64 + c8 * 8;
            kd[0] = bflo(kk.x); kd[1] = bfhi(kk.x); kd[2] = bflo(kk.y); kd[3] = bfhi(kk.y); kd[4] = bflo(kk.z); kd[5] = bfhi(kk.z); kd[6] = bflo(kk.w); kd[7] = bfhi(kk.w);
            vd[0] = bflo(vv.x); vd[1] = bfhi(vv.x); vd[2] = bflo(vv.y); vd[3] = bfhi(vv.y); vd[4] = bflo(vv.z); vd[5] = bfhi(vv.z); vd[6] = bflo(vv.w); vd[7] = bfhi(vv.w); }
        __syncthreads();
        const int i = half * 64 + lane; const size_t m = (size_t)b * T + nb * 128 + i;
        float q[64], o[64];
        { const bf16* qp = PROJ + m * EVEN_IN + 2048 + hq * 64;
#pragma unroll
          for (int c8 = 0; c8 < 8; ++c8) { const v4u t = *(const GAS v4u*)(qp + c8 * 8);
              q[c8 * 8 + 0] = bflo(t.x) * 0.125f; q[c8 * 8 + 1] = bfhi(t.x) * 0.125f; q[c8 * 8 + 2] = bflo(t.y) * 0.125f; q[c8 * 8 + 3] = bfhi(t.y) * 0.125f;
              q[c8 * 8 + 4] = bflo(t.z) * 0.125f; q[c8 * 8 + 5] = bfhi(t.z) * 0.125f; q[c8 * 8 + 6] = bflo(t.w) * 0.125f; q[c8 * 8 + 7] = bfhi(t.w) * 0.125f; } }
#pragma unroll
        for (int d = 0; d < 64; ++d) o[d] = 0.f;
        float mx = F.swa_sinks[j * 16 + hq], l = 1.0f;
        const LAS float* bt = btab + w * 128;
        const int jlo = half * 64 + 1, jhi = half * 64 + 63 + 128;
        for (int jk = jlo; jk <= jhi; ++jk) {
            const LAS f32x4* kr = (const LAS f32x4*)(Ks + jk * 64); float s = 0.f;
#pragma unroll
            for (int c4 = 0; c4 < 16; ++c4) { const f32x4 kv = kr[c4]; s += q[c4 * 4] * kv.x + q[c4 * 4 + 1] * kv.y + q[c4 * 4 + 2] * kv.z + q[c4 * 4 + 3] * kv.w; }
            const int dist = i + 128 - jk; const bool ok = (dist >= 0) && (dist < 128) && (nb * 128 + jk - 128 >= 0);
            s = ok ? s + bt[dist & 127] : -__builtin_inff();
            const float mn = fmaxf(mx, s), sc = __expf(mx - mn), pe = __expf(s - mn);
            l = l * sc + pe; mx = mn;
            const LAS f32x4* vr = (const LAS f32x4*)(Vs + jk * 64);
#pragma unroll
            for (int c4 = 0; c4 < 16; ++c4) { const f32x4 vv = vr[c4]; o[c4 * 4] = o[c4 * 4] * sc + pe * vv.x; o[c4 * 4 + 1] = o[c4 * 4 + 1] * sc + pe * vv.y; o[c4 * 4 + 2] = o[c4 * 4 + 2] * sc + pe * vv.z; o[c4 * 4 + 3] = o[c4 * 4 + 3] * sc + pe * vv.w; }
        }
        const float inv = 1.0f / l;
        bf16* op = MIX + m * D + LRU_W + hq * 64;
#pragma unroll
        for (int c8 = 0; c8 < 8; ++c8) { v4u t; t.x = pk2(o[c8 * 8] * inv, o[c8 * 8 + 1] * inv); t.y = pk2(o[c8 * 8 + 2] * inv, o[c8 * 8 + 3] * inv); t.z = pk2(o[c8 * 8 + 4] * inv, o[c8 * 8 + 5] * inv); t.w = pk2(o[c8 * 8 + 6] * inv, o[c8 * 8 + 7] * inv);
            *(GAS v4u*)(op + c8 * 8) = t; }
    }
    __syncthreads();
}

__device__ __forceinline__ void gla_gate_phase(Frame& F, int j) {
    LAS float* alr = (LAS float*)(F.lds + RING_OFF);
    const float* X = (const float*)(F.ws + WS_X); float* G = (float*)(F.ws + WS_GLA_G);
    const float* W = F.odd_w_in + (size_t)j * D * ODD_IN + ODD_N;
    const float* w2 = F.gla_w_alpha2 + (size_t)j * 16 * GLA_DK; const float* bal = F.gla_b_alpha + (size_t)j * GLA_DK;
    const int tid = F.tid;
    for (int unit = blockIdx.x; unit < M / 32; unit += F.G) {
        __syncthreads();
        { const int r = tid & 15, row = tid >> 4; const float* xr = X + (size_t)(unit * 32 + row) * D; float acc = 0.f;
          for (int k = 0; k < D; k += 4) { const f32x4 xv = *(const GAS f32x4*)(xr + k);
              acc += xv.x * W[(size_t)k * ODD_IN + r] + xv.y * W[(size_t)(k + 1) * ODD_IN + r] + xv.z * W[(size_t)(k + 2) * ODD_IN + r] + xv.w * W[(size_t)(k + 3) * ODD_IN + r]; }
          alr[row * 16 + r] = acc; }
        __syncthreads();
#pragma unroll
        for (int jj = 0; jj < 2; ++jj) { const int d = tid + jj * NTHR; float wc[16];
#pragma unroll
            for (int r = 0; r < 16; ++r) wc[r] = w2[r * GLA_DK + d];
            const float bb = bal[d];
            for (int row = 0; row < 32; ++row) { float lg = bb;
#pragma unroll
                for (int r = 0; r < 16; ++r) lg += alr[row * 16 + r] * wc[r];
                const float ls = fminf(lg, 0.f) - log1pf(expf(-fabsf(lg)));
                G[(size_t)(unit * 32 + row) * GLA_DK + d] = expf(ls * (1.0f / 16.0f)); } }
    }
    __syncthreads();
}
__device__ __forceinline__ void gla_scan_phase(Frame& F) {
    LAS float* red = (LAS float*)(F.lds + RING_OFF);
    const bf16* PROJ = (const bf16*)(F.ws + WS_PROJ); const float* G = (const float*)(F.ws + WS_GLA_G); float* O = (float*)(F.ws + WS_GLA_O);
    const int tid = F.tid, lane = F.lane, w = F.wave, e = tid & 15, d0 = (tid >> 4) * 8;
    for (int unit = blockIdx.x; unit < 256; unit += F.G) {
        const int es = unit & 31, h = (unit >> 5) & 3, b = unit >> 7, e0 = es * 16;
        float S[8];
#pragma unroll
        for (int i = 0; i < 8; ++i) S[i] = 0.f;
        for (int tb = 0; tb < T; tb += 8) {
            f32x4 g0[8], g1[8]; v4u kk[8], qq[8]; float vv[8];
#pragma unroll
            for (int tt = 0; tt < 8; ++tt) { const size_t m = (size_t)b * T + tb + tt; const bf16* rowp = PROJ + m * ODD_N;
                g0[tt] = *(const GAS f32x4*)(G + m * GLA_DK + h * 256 + d0); g1[tt] = *(const GAS f32x4*)(G + m * GLA_DK + h * 256 + d0 + 4);
                qq[tt] = *(const GAS v4u*)(rowp + h * 256 + d0); kk[tt] = *(const GAS v4u*)(rowp + 1024 + h * 256 + d0); vv[tt] = bf2f(rowp[2048 + h * 512 + e0 + e]); }
            __syncthreads();
#pragma unroll
            for (int tt = 0; tt < 8; ++tt) {
                const float v = vv[tt]; float part;
                S[0] = g0[tt].x * S[0] + bflo(kk[tt].x) * v; part = bflo(qq[tt].x) * S[0];
                S[1] = g0[tt].y * S[1] + bfhi(kk[tt].x) * v; part += bfhi(qq[tt].x) * S[1];
                S[2] = g0[tt].z * S[2] + bflo(kk[tt].y) * v; part += bflo(qq[tt].y) * S[2];
                S[3] = g0[tt].w * S[3] + bfhi(kk[tt].y) * v; part += bfhi(qq[tt].y) * S[3];
                S[4] = g1[tt].x * S[4] + bflo(kk[tt].z) * v; part += bflo(qq[tt].z) * S[4];
                S[5] = g1[tt].y * S[5] + bfhi(kk[tt].z) * v; part += bfhi(qq[tt].z) * S[5];
                S[6] = g1[tt].z * S[6] + bflo(kk[tt].w) * v; part += bflo(qq[tt].w) * S[6];
                S[7] = g1[tt].w * S[7] + bfhi(kk[tt].w) * v; part += bfhi(qq[tt].w) * S[7];
                part += __shfl_xor(part, 16); part += __shfl_xor(part, 32);
                if (lane < 16) red[(tt * 8 + w) * 16 + lane] = part;
            }
            __syncthreads();
            if (tid < 128) { const int tt = tid >> 4, ee = tid & 15; float s = 0.f;
#pragma unroll
                for (int ww = 0; ww < 8; ++ww) s += red[(tt * 8 + ww) * 16 + ee];
                O[((size_t)b * T + tb + tt) * GLA_DV + h * 512 + e0 + ee] = s * (1.0f / 16.0f); }
        }
    }
    __syncthreads();
}
__device__ __forceinline__ void gla_post_phase(Frame& F, int j) {
    const bf16* PROJ = (const bf16*)(F.ws + WS_PROJ); const float* O = (const float*)(F.ws + WS_GLA_O); bf16* MIX = (bf16*)(F.ws + WS_MIX);
    const float* ng = F.gla_norm_g + (size_t)j * GLA_HV;
    const int gw = F.vcu * NWAVES + F.wave, NGW = F.G * NWAVES, lane = F.lane;
    const f32x4 n0 = *(const GAS f32x4*)(ng + lane * 8), n1 = *(const GAS f32x4*)(ng + lane * 8 + 4);
    for (int it = gw; it < M * 4; it += NGW) { const int h = it & 3; const size_t m = it >> 2;
        const f32x4 a = *(const GAS f32x4*)(O + m * GLA_DV + h * 512 + lane * 8), c = *(const GAS f32x4*)(O + m * GLA_DV + h * 512 + lane * 8 + 4);
        const v4u rr = *(const GAS v4u*)(PROJ + m * ODD_N + 4096 + h * 512 + lane * 8);
        const float ss = wave_sum((a.x * a.x + a.y * a.y) + (a.z * a.z + a.w * a.w) + (c.x * c.x + c.y * c.y) + (c.z * c.z + c.w * c.w));
        const float rs = 1.0f / sqrtf(ss * (1.0f / 512.0f) + RMS_EPS);
        float r[8] = {bflo(rr.x), bfhi(rr.x), bflo(rr.y), bfhi(rr.y), bflo(rr.z), bfhi(rr.z), bflo(rr.w), bfhi(rr.w)};
        float ov[8] = {a.x * rs * n0.x, a.y * rs * n0.y, a.z * rs * n0.z, a.w * rs * n0.w, c.x * rs * n1.x, c.y * rs * n1.y, c.z * rs * n1.z, c.w * rs * n1.w};
        float y[8];
#pragma unroll
        for (int i = 0; i < 8; ++i) y[i] = ov[i] * (r[i] * sigmoid_f(r[i]));
        v4u t; t.x = pk2(y[0], y[1]); t.y = pk2(y[2], y[3]); t.z = pk2(y[4], y[5]); t.w = pk2(y[6], y[7]);
        *(GAS v4u*)(MIX + m * D + h * 512 + lane * 8) = t; }
}

typedef short bf16x8 __attribute__((ext_vector_type(8)));
#define MFMA16(a, b, c) __builtin_amdgcn_mfma_f32_16x16x32_bf16((a), (b), (c), 0, 0, 0)
__device__ __forceinline__ float log_sigmoid_fast(float x) { return fminf(x, 0.f) - __logf(1.0f + __expf(-fabsf(x))); }
__device__ __forceinline__ void gla_pre_phase(Frame& F, int j) {
    LAS unsigned char* L = F.lds + RING_OFF;
    LAS bf16* vts = (LAS bf16*)L;
    LAS float* part = (LAS float*)L;
    LAS float* alr = (LAS float*)(L + 32768);
    LAS float* tot = (LAS float*)(L + 36864);
    LAS bf16* qt = (LAS bf16*)(L + 40960);
    LAS bf16* kb = (LAS bf16*)(L + 74752);
    const bf16* PROJ = (const bf16*)(F.ws + WS_PROJ); const bf16* XB = (const bf16*)(F.ws + WS_XB);
    bf16* QT = (bf16*)(F.ws + WS_GLA_QT); bf16* KT = (bf16*)(F.ws + WS_GLA_KT); bf16* VT = (bf16*)(F.ws + WS_GLA_VT); bf16* AI = (bf16*)(F.ws + WS_GLA_AI); float* GAM = (float*)(F.ws + WS_GLA_GAM);
    const bf16* WALR = (const bf16*)(F.ws + WS_WALR) + (size_t)j * 16 * D;
    const float* w2 = F.gla_w_alpha2 + (size_t)j * 16 * GLA_DK; const float* bal = F.gla_b_alpha + (size_t)j * GLA_DK;
    const int tid = F.tid, lane = F.lane, w = F.wave, g = lane >> 4, fr = lane & 15;
    for (int unit = blockIdx.x; unit < 512; unit += F.G) {
        const int c = unit & 63, h = (unit >> 6) & 3, b = unit >> 8, u = (b * 4 + h) * 64 + c; const size_t m0 = (size_t)b * T + c * 64;
        __syncthreads();
#pragma unroll
        for (int i = 0; i < 8; ++i) { const int idx = tid + NTHR * i, row = idx >> 6, c16 = idx & 63;
            *(LAS v4u*)(vts + row * 520 + c16 * 8) = *(const GAS v4u*)(PROJ + (m0 + row) * ODD_N + 2048 + h * 512 + c16 * 8); }
        __syncthreads();
#pragma unroll
        for (int i = 0; i < 8; ++i) { const int idx = tid + NTHR * i, e = idx >> 3, sg = idx & 7; const LAS bf16* s = vts + (sg * 8) * 520 + e;
            v4u o; o.x = (unsigned)s[0] | ((unsigned)s[520] << 16); o.y = (unsigned)s[2 * 520] | ((unsigned)s[3 * 520] << 16); o.z = (unsigned)s[4 * 520] | ((unsigned)s[5 * 520] << 16); o.w = (unsigned)s[6 * 520] | ((unsigned)s[7 * 520] << 16);
            *(GAS v4u*)(VT + ((size_t)u * 512 + e) * 64 + sg * 8) = o; }
        __syncthreads();
        { f32x4 acc[4];
#pragma unroll
          for (int rt = 0; rt < 4; ++rt) acc[rt] = (f32x4){0.f, 0.f, 0.f, 0.f};
#pragma unroll
          for (int ks = 0; ks < 8; ++ks) { const int kk = 256 * w + 32 * ks + 8 * g;
              const bf16x8 bfr = *(const GAS bf16x8*)(WALR + (size_t)fr * D + kk);
#pragma unroll
              for (int rt = 0; rt < 4; ++rt) { const bf16x8 afr = *(const GAS bf16x8*)(XB + (m0 + 16 * rt + fr) * D + kk); acc[rt] = MFMA16(afr, bfr, acc[rt]); } }
#pragma unroll
          for (int rt = 0; rt < 4; ++rt)
#pragma unroll
              for (int r = 0; r < 4; ++r) part[w * 1024 + (16 * rt + 4 * g + r) * 16 + fr] = acc[rt][r]; }
        __syncthreads();
#pragma unroll
        for (int i = 0; i < 2; ++i) { const int idx = tid + NTHR * i; float s = 0.f;
#pragma unroll
            for (int ww = 0; ww < 8; ++ww) s += part[ww * 1024 + idx];
            alr[idx] = s; }
        __syncthreads();
        {
            const int d = tid & 255, hf = tid >> 8, hd = h * 256 + d;
            float w2c[16];
#pragma unroll
            for (int r = 0; r < 16; ++r) w2c[r] = w2[r * GLA_DK + hd];
            const float bias = bal[hd];
#define GLA_LOGDECAY(t_, out_) do { float lg_ = bias; \
                _Pragma("unroll") for (int r4 = 0; r4 < 4; ++r4) { const f32x4 av = *(const LAS f32x4*)(alr + (t_) * 16 + r4 * 4); lg_ += av.x * w2c[r4 * 4] + av.y * w2c[r4 * 4 + 1] + av.z * w2c[r4 * 4 + 2] + av.w * w2c[r4 * 4 + 3]; } \
                out_ = log_sigmoid_fast(lg_) * (1.0f / 16.0f); } while (0)
            float run = 0.f;
#pragma unroll 4
            for (int i = 0; i < 32; ++i) { float ls; GLA_LOGDECAY(32 * hf + i, ls); run += ls; }
            tot[hf * 256 + d] = run;
            __syncthreads();
            const float blast = tot[d] + tot[256 + d];
            run = hf ? tot[d] : 0.f;
            if (hf == 0) *(GAS float*)(GAM + (size_t)u * 256 + d) = __expf(blast);
            const int x = d & 31, pos = 8 * ((x & 15) >> 2) + (x & 3) + ((x >> 4) << 2);
            const GAS bf16* pq = (const GAS bf16*)(PROJ + (m0 + 32 * hf) * ODD_N + hd);
            GAS bf16* qdst = (GAS bf16*)(QT + (m0 + 32 * hf) * GLA_DK + h * 256 + (d & ~31) + pos);
            GAS bf16* kdst = (GAS bf16*)(KT + ((size_t)u * 256 + d) * 64 + 32 * hf);
#pragma unroll 1
            for (int q4 = 0; q4 < 4; ++q4) { unsigned kh[4];
#pragma unroll
                for (int i8 = 0; i8 < 8; ++i8) { const int i = 8 * q4 + i8, t = 32 * hf + i; float ls; GLA_LOGDECAY(t, ls); run += ls;
                    const float qv = bf2f(pq[(size_t)i * ODD_N]), kv = bf2f(pq[(size_t)i * ODD_N + 1024]);
                    const unsigned bq = f2bf(qv * __expf(run) * (1.0f / 16.0f));
                    qt[t * 264 + d] = (bf16)bq; kb[t * 264 + d] = (bf16)f2bf(kv * __expf(-run));
                    qdst[(size_t)i * GLA_DK] = (bf16)bq;
                    const unsigned kq = f2bf(kv * __expf(blast - run));
                    if (i8 & 1) kh[i8 >> 1] |= kq << 16; else kh[i8 >> 1] = kq; }
                *(GAS v4u*)(kdst + 8 * q4) = (v4u){kh[0], kh[1], kh[2], kh[3]}; }
#undef GLA_LOGDECAY
        }
        __syncthreads();
#pragma unroll
        for (int q2 = 0; q2 < 2; ++q2) { const int ti = 2 * w + q2, ttile = ti >> 2, stile = ti & 3;
            f32x4 acc = (f32x4){0.f, 0.f, 0.f, 0.f};
            if (stile <= ttile) {
#pragma unroll
                for (int ks = 0; ks < 8; ++ks) { const bf16x8 a = *(const LAS bf16x8*)(kb + (16 * stile + fr) * 264 + 32 * ks + 8 * g), bq = *(const LAS bf16x8*)(qt + (16 * ttile + fr) * 264 + 32 * ks + 8 * g);
                    acc = MFMA16(a, bq, acc); } }
            const int t = 16 * ttile + fr, s0 = 16 * stile + 4 * g;
            v2u o; o.x = pk2(s0 <= t ? acc[0] : 0.f, s0 + 1 <= t ? acc[1] : 0.f); o.y = pk2(s0 + 2 <= t ? acc[2] : 0.f, s0 + 3 <= t ? acc[3] : 0.f);
            *(GAS v2u*)(AI + ((size_t)u * 64 + t) * 64 + s0) = o; }
    }
    __syncthreads();
}
__device__ __forceinline__ void gla_seq_phase(Frame& F) {
    LAS v4u* sbuf = (LAS v4u*)(F.lds + RING_OFF);
    const bf16* QT = (const bf16*)(F.ws + WS_GLA_QT); const bf16* KT = (const bf16*)(F.ws + WS_GLA_KT); const bf16* VT = (const bf16*)(F.ws + WS_GLA_VT); const bf16* AI = (const bf16*)(F.ws + WS_GLA_AI);
    const float* GAM = (const float*)(F.ws + WS_GLA_GAM); float* O = (float*)(F.ws + WS_GLA_O);
    const int lane = F.lane, w = F.wave, g = lane >> 4, fr = lane & 15, tt = w & 3, eo = w >> 2;
    for (int task = blockIdx.x; task < 128; task += F.G) {
        const int es = task & 15, h = (task >> 4) & 3, b = task >> 6, e0 = es * 32; const size_t u0 = (size_t)(b * 4 + h) * 64;
        const bf16* KTb = KT + (u0 * 256 + 32 * w + fr) * 64 + 8 * g;
        const bf16* VTb = VT + (u0 * 512 + e0 + fr) * 64 + 8 * g;
        const float* GMb = GAM + u0 * 256 + 32 * w + 4 * g;
        const bf16* AIb = AI + (u0 * 64 + 16 * tt + fr) * 64 + 8 * g;
        const bf16* QTb = QT + ((size_t)b * T + 16 * tt + fr) * GLA_DK + h * 256 + 8 * g;
        float* Ob = O + ((size_t)b * T + 16 * tt + 4 * g) * GLA_DV + h * 512 + e0 + 16 * eo + fr;
        f32x4 S[2][2];
#pragma unroll
        for (int dt = 0; dt < 2; ++dt)
#pragma unroll
            for (int en = 0; en < 2; ++en) S[dt][en] = (f32x4){0.f, 0.f, 0.f, 0.f};
        bf16x8 kt[2][2], vt[2][2], ai[2], qf[8]; f32x4 gm[2];
#define GLA_LOAD_A(KT_, VT_, GM_, AI_, c_) do { \
        _Pragma("unroll") for (int dt = 0; dt < 2; ++dt) { GM_[dt] = *(const GAS f32x4*)(GMb + (size_t)(c_) * 256 + dt * 16); \
            _Pragma("unroll") for (int k2 = 0; k2 < 2; ++k2) { KT_[dt][k2] = *(const GAS bf16x8*)(KTb + (size_t)(c_) * 16384 + dt * 1024 + k2 * 32); VT_[dt][k2] = *(const GAS bf16x8*)(VTb + (size_t)(c_) * 32768 + dt * 1024 + k2 * 32); } } \
        _Pragma("unroll") for (int k2 = 0; k2 < 2; ++k2) AI_[k2] = *(const GAS bf16x8*)(AIb + (size_t)(c_) * 4096 + k2 * 32); } while (0)
#define GLA_LOAD_Q(c_) do { _Pragma("unroll") for (int ks = 0; ks < 8; ++ks) qf[ks] = *(const GAS bf16x8*)(QTb + (size_t)(c_) * 65536 + ks * 32); } while (0)
        GLA_LOAD_A(kt, vt, gm, ai, 0); GLA_LOAD_Q(0);
        for (int c = 0; c < 64; ++c) {
            LAS v4u* sb = sbuf + (c & 1) * 1024;
#pragma unroll
            for (int en = 0; en < 2; ++en) { v4u p; p.x = pg8::cvt_pk_bf16(S[0][en][0], S[0][en][1]); p.y = pg8::cvt_pk_bf16(S[0][en][2], S[0][en][3]); p.z = pg8::cvt_pk_bf16(S[1][en][0], S[1][en][1]); p.w = pg8::cvt_pk_bf16(S[1][en][2], S[1][en][3]);
                sb[(w * 2 + en) * 64 + lane] = p; }
            bf16x8 nkt[2][2], nvt[2][2], nai[2]; f32x4 ngm[2];
            const int cn = c + 1 < 64 ? c + 1 : c;
            GLA_LOAD_A(nkt, nvt, ngm, nai, cn);
            __syncthreads();
            f32x4 o = (f32x4){0.f, 0.f, 0.f, 0.f};
#pragma unroll
            for (int ks = 0; ks < 8; ++ks) { const v4u sv = sb[(ks * 2 + eo) * 64 + lane]; o = MFMA16(qf[ks], __builtin_bit_cast(bf16x8, sv), o); }
#pragma unroll
            for (int k2 = 0; k2 < 2; ++k2) o = MFMA16(ai[k2], vt[eo][k2], o);
            { float* op = Ob + (size_t)c * 131072;
#pragma unroll
              for (int r = 0; r < 4; ++r) op[(size_t)r * GLA_DV] = o[r]; }
            GLA_LOAD_Q(cn);
#pragma unroll
            for (int dt = 0; dt < 2; ++dt)
#pragma unroll
                for (int en = 0; en < 2; ++en) { f32x4 s = S[dt][en] * gm[dt];
#pragma unroll
                    for (int k2 = 0; k2 < 2; ++k2) s = MFMA16(kt[dt][k2], vt[en][k2], s);
                    S[dt][en] = s; }
#pragma unroll
            for (int dt = 0; dt < 2; ++dt) { gm[dt] = ngm[dt];
#pragma unroll
                for (int k2 = 0; k2 < 2; ++k2) { kt[dt][k2] = nkt[dt][k2]; vt[dt][k2] = nvt[dt][k2]; } }
            ai[0] = nai[0]; ai[1] = nai[1];
        }
#undef GLA_LOAD_A
#undef GLA_LOAD_Q
        __syncthreads();
    }
}

__host__ __device__ inline bool phase_active(int p) {
    if (p == 0) return true;
    const int s = (p - 1) / SLOTS, k = (p - 1) % SLOTS, l = s / 3, kind = s % 3;
    if (k == 0 || k == 4 || k == 5) return true;
    if (kind != 1) return false;
    if ((l & 1) == 0) return k == 1 || k == 2;
    return true;
}
struct Args { const float* in[22]; float* out; unsigned char* ws; int ph_lo, ph_hi; };
__global__ void __launch_bounds__(NTHR, 2) mk_fwd(Args args) {
    extern __shared__ __attribute__((aligned(16))) unsigned char lds[];
    Frame F;
    F.lds = (LAS unsigned char*)lds;
    F.MISC = (volatile LAS unsigned*)(F.lds + MISC_OFF);
    F.tid = threadIdx.x; F.lane = F.tid & 63; F.wave = __builtin_amdgcn_readfirstlane(F.tid >> 6);
    F.G = gridDim.x; { const int bx = blockIdx.x; F.vcu = (F.G % 8 == 0) ? (bx % 8) * (F.G / 8) + bx / 8 : bx; }
    F.ws = args.ws; F.ctl = (gu32*)(args.ws + WS_CTL); F.out = args.out;
    F.xin = args.in[0]; F.w_gate = args.in[1]; F.w_up = args.in[2]; F.w_down = args.in[3]; F.ln_g = args.in[4]; F.ln_b = args.in[5]; F.even_w_in = args.in[6]; F.conv_w = args.in[7]; F.conv_b = args.in[8];
    F.lru_wa = args.in[9]; F.lru_ba = args.in[10]; F.lru_wx = args.in[11]; F.lru_bx = args.in[12]; F.lru_lambda = args.in[13]; F.swa_sinks = args.in[14]; F.even_w_out = args.in[15]; F.rel_bias = args.in[16];
    F.odd_w_in = args.in[17]; F.gla_w_alpha2 = args.in[18]; F.gla_b_alpha = args.in[19]; F.gla_norm_g = args.in[20]; F.odd_w_out = args.in[21];
    for (int u = F.tid; u < (LDS_BYTES - LDSCTL_OFF) / 4; u += NTHR) ((LAS unsigned*)(F.lds + LDSCTL_OFF))[u] = 0u;
    __syncthreads();
#if MK_MULTI
#define GRID_BAR() do { } while (0)
#else
    XcdBarrier bar = xcd_barrier_post((unsigned*)(F.ctl + CW_BAR), F.MISC + 8);
#define GRID_BAR() xcd_barrier(bar)
#endif
    const int lo = args.ph_lo, hi = args.ph_hi;
#define IN(k) (lo <= (k) && (k) < hi)
#define REFRESH() do { int t_ = threadIdx.x; asm volatile("" : "+v"(t_)); F.tid = t_; F.lane = t_ & 63; F.wave = __builtin_amdgcn_readfirstlane(t_ >> 6); unsigned char* w_ = args.ws; asm volatile("" : "+s"(w_)); F.ws = w_; } while (0)
#define SEAM(k) do { if ((k) + 1 < hi) GRID_BAR(); } while (0)
#define X ((float*)(F.ws + WS_X))
#define Y ((float*)(F.ws + WS_Y))
#define XB ((bf16*)(F.ws + WS_XB))
#define H ((bf16*)(F.ws + WS_H))
#define PROJ ((bf16*)(F.ws + WS_PROJ))
#define MIX ((bf16*)(F.ws + WS_MIX))

    for (int rep_ = 0; rep_ < REP_P0; ++rep_)
    if (IN(0)) { REFRESH(); p0_prologue(F); SEAM(0); }

    for (int s = 0; s < NSUB; ++s) {
        const int l = s / 3, kind = s % 3, j = l >> 1, pb = 1 + s * SLOTS, odd = l & 1;
        const int fi = l * 2 + (kind == 2 ? 1 : 0);
        for (int rep_ = 0; rep_ < REP_IN; ++rep_)
        if (IN(pb + 0)) {
            REFRESH();
            if (kind != 1) {
                pg8::Gemm g{XB, (const bf16*)(F.ws + WS_WGU + (size_t)fi * SZ_WGU), M, 2 * FF, D}; pg8::StaticOrder S; S.init(M, 2 * FF, F.G, (int)blockIdx.x);
                pg8::EpiSwiGLU E{H, FF};
                pg8::gemm_phase<pg8::EpiSwiGLU, pg8::StaticOrder, PG8_ALIGN, PG8_SP2>(F.lds + RING_OFF, g, S, E);
            } else {
                const int N = odd ? ODD_N : EVEN_IN;
                const bf16* Wt = odd ? (const bf16*)(F.ws + WS_WOIN + (size_t)j * SZ_WOIN) : (const bf16*)(F.ws + WS_WEIN + (size_t)j * SZ_WEIN);
                pg8::Gemm g{XB, Wt, M, N, D}; pg8::StaticOrder S; S.init(M, N, F.G, (int)blockIdx.x);
                pg8::EpiPlainBf16 E{PROJ, N};
                pg8::gemm_phase<pg8::EpiPlainBf16, pg8::StaticOrder, PG8_ALIGN, PG8_SP2>(F.lds + RING_OFF, g, S, E);
            }
            SEAM(pb + 0);
        }
        if (kind == 1) {
            if (!odd) {
                if (IN(pb + 1)) { REFRESH(); lru_local_phase(F, j); REFRESH(); swa_phase(F, j); SEAM(pb + 1); }
#ifdef DUP_EVEN1
                if (IN(pb + 1)) { REFRESH(); lru_local_phase(F, j); SEAM(pb + 1); }
#endif
#ifdef DUP_EVEN2
                if (IN(pb + 1)) { REFRESH(); swa_phase(F, j); SEAM(pb + 1); }
#endif
                if (IN(pb + 2)) { REFRESH(); lru_fix_phase(F); SEAM(pb + 2); }
#ifdef DUP_EVEN3
                if (IN(pb + 2)) { REFRESH(); lru_fix_phase(F); SEAM(pb + 2); }
#endif
            } else {
                if (IN(pb + 1)) { REFRESH(); gla_pre_phase(F, j); SEAM(pb + 1); }
#ifdef DUP_ODD1
                if (IN(pb + 1)) { REFRESH(); gla_pre_phase(F, j); SEAM(pb + 1); }
#endif
                if (IN(pb + 2)) { REFRESH(); gla_seq_phase(F); SEAM(pb + 2); }
#ifdef DUP_ODD2
                if (IN(pb + 2)) { REFRESH(); gla_seq_phase(F); SEAM(pb + 2); }
#endif
                if (IN(pb + 3)) { REFRESH(); gla_post_phase(F, j); SEAM(pb + 3); }
            }
        }
        for (int rep_ = 0; rep_ < REP_OUT; ++rep_)
        if (IN(pb + 4)) {
            REFRESH();
            const bf16* A = kind != 1 ? H : MIX; const int K = kind != 1 ? FF : D;
            const bf16* Wt = kind != 1 ? (const bf16*)(F.ws + WS_WD + (size_t)fi * SZ_WD) : (odd ? (const bf16*)(F.ws + WS_WOOUT + (size_t)j * SZ_WOUT) : (const bf16*)(F.ws + WS_WEOUT + (size_t)j * SZ_WOUT));
            pg8::Gemm g{A, Wt, M, D, K}; pg8::StaticOrder S; S.init(M, D, F.G, (int)blockIdx.x);
            pg8::EpiResid E{s == 0 ? F.xin : X, Y, D, DN_ALPHA, kind != 1 ? 0.5f : 1.0f};
            pg8::gemm_phase<pg8::EpiResid, pg8::StaticOrder, PG8_ALIGN, PG8_SP2>(F.lds + RING_OFF, g, S, E);
            SEAM(pb + 4);
        }
        for (int rep_ = 0; rep_ < REP_LN; ++rep_)
        if (IN(pb + 5)) {
            REFRESH();
            ln_phase(F, Y, F.ln_g + (size_t)(l * 3 + kind) * D, F.ln_b + (size_t)(l * 3 + kind) * D, s == NSUB - 1 ? F.out : X, XB);
            SEAM(pb + 5);
        }
    }
#undef IN
#undef SEAM
#undef X
#undef Y
#undef XB
#undef H
#undef PROJ
#undef MIX
}

extern "C" void kernel_launch(void* const* d_in, const int* in_sizes, int n_in, void* d_out, int out_size, void* d_ws, size_t ws_size, hipStream_t stream) {
    static int grid = 0;
    if (grid == 0) {
        if (n_in != 22 || in_sizes[0] != M * D || out_size != M * D || ws_size < WS_END) { fprintf(stderr, "kernel_launch: unexpected shapes (n_in %d, in0 %d, out %d, ws %zu < %zu); nothing launched\n", n_in, n_in > 0 ? in_sizes[0] : -1, out_size, ws_size, (size_t)WS_END); grid = -1; return; }
        int dev = 0, cus = 0, per_cu = 0;
        if (hipGetDevice(&dev) != hipSuccess || hipDeviceGetAttribute(&cus, hipDeviceAttributeMultiprocessorCount, dev) != hipSuccess) { grid = -1; return; }
        if (hipFuncSetAttribute((const void*)mk_fwd, hipFuncAttributeMaxDynamicSharedMemorySize, LDS_BYTES) != hipSuccess) { fprintf(stderr, "kernel_launch: hipFuncSetAttribute failed\n"); grid = -1; return; }
        if (hipOccupancyMaxActiveBlocksPerMultiprocessor(&per_cu, (const void*)mk_fwd, NTHR, LDS_BYTES) != hipSuccess || per_cu < 1) { fprintf(stderr, "kernel_launch: occupancy query says %d blocks per CU\n", per_cu); }
        (void)hipGetLastError();
        grid = cus;
    }
    if (grid < 0) return;
    (void)hipMemsetAsync((char*)d_ws + WS_CTL, 0, CTL_ZERO_BYTES, stream);
    Args a{};
    for (int i = 0; i < 22; ++i) a.in[i] = (const float*)d_in[i];
    a.out = (float*)d_out; a.ws = (unsigned char*)d_ws;
#if MK_MULTI
    for (int p = 0; p < NPHASE; ++p) { if (!phase_active(p)) continue; a.ph_lo = p; a.ph_hi = p + 1; hipLaunchKernelGGL(mk_fwd, dim3(grid), dim3(NTHR), LDS_BYTES, stream, a); }
#else
    a.ph_lo = 0; a.ph_hi = NPHASE; hipLaunchKernelGGL(mk_fwd, dim3(grid), dim3(NTHR), LDS_BYTES, stream, a);
#endif
    const hipError_t le = hipPeekAtLastError();
    if (le != hipSuccess) fprintf(stderr, "kernel_launch: launch failed: %s\n", hipGetErrorName(le));
}
```

```cpp
#include <hip/hip_runtime.h>
#include <cstdio>
#include <cstdint>
namespace pg8 {
#define PG8_LAS __attribute__((address_space(3)))
typedef unsigned short bf16_t;
typedef short bf16x8 __attribute__((ext_vector_type(8)));
typedef float f32x4 __attribute__((ext_vector_type(4)));
typedef unsigned u32x4 __attribute__((ext_vector_type(4)));
constexpr int BM = 256, BK = 64, HALF = 128, HTB = HALF * BK * 2  , STAGE_BYTES = 8 * HTB, NXCD = 8, WGM = 8;

__host__ __device__ __forceinline__ int lds_byte(int r, int c) { const int st = (r >> 4) * 2 + (c >> 5), rr = r & 15, cc = c & 31, ob = rr * 64 + cc * 2; return st * 1024 + (ob ^ (((ob >> 9) & 1) << 5)); }
__host__ __device__ __forceinline__ void stage_rc(int b, int& R, int& C) { const int st = b / 1024, sb = b % 1024, swz = sb ^ (((sb >> 9) & 1) << 5); R = (st >> 1) * 16 + swz / 64; C = (st & 1) * 32 + (swz % 64) / 2; }
__host__ __device__ __forceinline__ int perm32(int rho) { const int n = rho >> 4, i = rho & 15; return 8 * (i >> 2) + 4 * n + (i & 3); }

struct Unit { int pm, pn; };
struct Gemm { const bf16_t* A; const bf16_t* Bt; int M, N, K; };

struct StaticOrder {
    int nM, nN, nwg, G, c;
    __host__ __device__ void init(int M, int N, int G_, int c_) { nM = M / BM; nN = N / BM; nwg = nM * nN; G = G_; c = c_; }
    __host__ __device__ bool next(int i, Unit& u) const {
        const long L = (long)i * G + c; if (L >= nwg) return false;
        int wgid = (int)L; { const int q = nwg / NXCD, r = nwg % NXCD, xcd = wgid % NXCD, off = wgid / NXCD; wgid = (xcd < r ? xcd * (q + 1) : r * (q + 1) + (xcd - r) * q) + off; }
        const int nig = WGM * nN, gid = wgid / nig, fm = gid * WGM, gsz = (nM - fm) < WGM ? (nM - fm) : WGM;
        u.pm = fm + ((wgid % nig) % gsz); u.pn = (wgid % nig) / gsz; return true;
    }
    __device__ __forceinline__ void a_ready(const Unit&) const {}
    __device__ __forceinline__ void done(const Unit&) const {}
};

__device__ __forceinline__ unsigned cvt_pk_bf16(float lo, float hi) { unsigned r; asm volatile("v_cvt_pk_bf16_f32 %0, %1, %2" : "=v"(r) : "v"(lo), "v"(hi)); return r; }
typedef float f32x2 __attribute__((ext_vector_type(2)));
__device__ __forceinline__ float silu_f(float g) { return g * __builtin_amdgcn_rcpf(1.0f + __expf(-g)); }
struct EpiPlainBf16 {
    static constexpr bool PERM = true, AFTER_DRAIN = false;
    bf16_t* O; int ldc;
    __device__ __forceinline__ void operator()(const f32x4 (&acc)[2][2][4][2], const Unit& u, int wr, int wc, int fr, int fq) const {
        const int row0 = u.pm * BM + wr * 64 + fr, col0 = u.pn * BM + wc * 32 + 8 * fq;
#pragma unroll
        for (int ai = 0; ai < 2; ++ai)
#pragma unroll
            for (int m = 0; m < 4; ++m) { bf16_t* rowp = O + (size_t)(row0 + ai * HALF + m * 16) * ldc + col0;
#pragma unroll
                for (int bj = 0; bj < 2; ++bj) { const f32x4 v0 = acc[ai][bj][m][0], v1 = acc[ai][bj][m][1];
                    u32x4 w; w.x = cvt_pk_bf16(v0[0], v0[1]); w.y = cvt_pk_bf16(v0[2], v0[3]); w.z = cvt_pk_bf16(v1[0], v1[1]); w.w = cvt_pk_bf16(v1[2], v1[3]);
                    *(u32x4*)(rowp + bj * HALF) = w; } }
    }
};
struct EpiSwiGLU {
    static constexpr bool PERM = true, AFTER_DRAIN = false;
    bf16_t* O; int ldc;
    __device__ __forceinline__ void operator()(const f32x4 (&acc)[2][2][4][2], const Unit& u, int wr, int wc, int fr, int fq) const {
        const int row0 = u.pm * BM + wr * 64 + fr, col0 = u.pn * HALF + wc * 32 + 8 * fq;
#pragma unroll
        for (int ai = 0; ai < 2; ++ai)
#pragma unroll
            for (int m = 0; m < 4; ++m) { bf16_t* rowp = O + (size_t)(row0 + ai * HALF + m * 16) * ldc + col0;
                const f32x4 g0 = acc[ai][0][m][0], g1 = acc[ai][0][m][1], u0 = acc[ai][1][m][0], u1 = acc[ai][1][m][1];
                u32x4 w;
                w.x = cvt_pk_bf16(silu_f(g0[0]) * u0[0], silu_f(g0[1]) * u0[1]); w.y = cvt_pk_bf16(silu_f(g0[2]) * u0[2], silu_f(g0[3]) * u0[3]);
                w.z = cvt_pk_bf16(silu_f(g1[0]) * u1[0], silu_f(g1[1]) * u1[1]); w.w = cvt_pk_bf16(silu_f(g1[2]) * u1[2], silu_f(g1[3]) * u1[3]);
                *(u32x4*)rowp = w; }
    }
};
struct EpiResid {
    static constexpr bool PERM = false, AFTER_DRAIN = false;
    const float* R; float* Y; int ldc; float alpha, beta;
    __device__ __forceinline__ void operator()(const f32x4 (&acc)[2][2][4][2], const Unit& u, int wr, int wc, int fr, int fq) const {
        const int row0 = u.pm * BM + wr * 64 + fr, col0 = u.pn * BM + wc * 32 + 4 * fq;
#pragma unroll
        for (int ai = 0; ai < 2; ++ai)
#pragma unroll
            for (int m = 0; m < 4; ++m) { const size_t off = (size_t)(row0 + ai * HALF + m * 16) * ldc + col0;
#pragma unroll
                for (int bj = 0; bj < 2; ++bj)
#pragma unroll
                    for (int n = 0; n < 2; ++n) { const f32x4 r = *(const f32x4*)(R + off + bj * HALF + n * 16);
                        *(f32x4*)(Y + off + bj * HALF + n * 16) = r * alpha + acc[ai][bj][m][n] * beta; }
                asm volatile("" ::: "memory"); }
    }
};

template <class Epi, class Sched, bool ALIGN_EPI = false, bool SP2 = false>
__device__ __forceinline__ void gemm_phase(PG8_LAS unsigned char* lds, const Gemm g, const Sched& S, const Epi& E) {
    int tid_ = threadIdx.x; asm volatile("" : "+v"(tid_));
    const int tid = tid_, wid = __builtin_amdgcn_readfirstlane(tid >> 6), lane = tid & 63, wr = wid >> 2, wc = wid & 3, fr = lane & 15, fq = lane >> 4;
    const int K = g.K, nt = K / BK;
    unsigned voffA[2], voffB[2];
#pragma unroll
    for (int i = 0; i < 2; ++i) { int R, C; stage_rc(tid * 16 + i * 8192, R, C); const int Rb = Epi::PERM ? ((R & ~31) + perm32(R & 31)) : R;
        voffA[i] = (unsigned)(R * K + C) * 2u; voffB[i] = (unsigned)(Rb * K + C) * 2u; }
    const size_t kstep = (size_t)(BK * 2);
    const size_t hstep = (size_t)HALF * K * 2;
    const size_t tstep = 2 * hstep;
    const unsigned ldsw = (unsigned)wid * 1024u;
    const int aoff = lds_byte(wr * 64 + fr, fq * 8), boff = lds_byte(wc * 32 + fr, fq * 8);
#define PG8_SA(b, h) (((b) * 2 + (h)) * HTB)
#define PG8_SB(b, h) ((4 + (b) * 2 + (h)) * HTB)
#define PG8_STAGE(bufoff, gbase, voff) do { _Pragma("unroll") for (int _i = 0; _i < 2; ++_i) \
        __builtin_amdgcn_global_load_lds((const unsigned*)((const char*)(gbase) + (voff)[_i]), (PG8_LAS unsigned*)(lds + (bufoff) + ldsw + _i * 8192), 16, 0, 0); } while (0)
#define PG8_LDA(dst, b, h) do { _Pragma("unroll") for (int m = 0; m < 4; ++m) _Pragma("unroll") for (int k = 0; k < 2; ++k) dst[m][k] = *(const PG8_LAS bf16x8*)(lds + PG8_SA(b, h) + aoff + m * 2048 + k * 1024); } while (0)
#define PG8_LDB(dst, b, h) do { _Pragma("unroll") for (int n = 0; n < 2; ++n) _Pragma("unroll") for (int k = 0; k < 2; ++k) dst[n][k] = *(const PG8_LAS bf16x8*)(lds + PG8_SB(b, h) + boff + n * 2048 + k * 1024); } while (0)
#define PG8_MMA(ai, bj, At, Bt) do { __builtin_amdgcn_s_setprio(1); _Pragma("unroll") for (int m = 0; m < 4; ++m) _Pragma("unroll") for (int n = 0; n < 2; ++n) _Pragma("unroll") for (int k = 0; k < 2; ++k) \
        acc[ai][bj][m][n] = __builtin_amdgcn_mfma_f32_16x16x32_bf16(Bt[n][k], At[m][k], acc[ai][bj][m][n], 0, 0, 0); __builtin_amdgcn_s_setprio(0); } while (0)
#define PG8_WAIT_V(n) asm volatile("s_waitcnt vmcnt(" #n ")" ::: "memory")
#define PG8_WAIT_L(n) asm volatile("s_waitcnt lgkmcnt(" #n ")" ::: "memory")
#define PG8_BAR __builtin_amdgcn_s_barrier()
#define PG8_SCHED __builtin_amdgcn_sched_barrier(0)
    Unit cur, nxt; int ui = 0;
    if (!S.next(0, cur)) return;
    f32x4 acc[2][2][4][2];
#pragma unroll
    for (int a = 0; a < 2; ++a)
#pragma unroll
        for (int b = 0; b < 2; ++b)
#pragma unroll
            for (int m = 0; m < 4; ++m)
#pragma unroll
                for (int n = 0; n < 2; ++n) acc[a][b][m][n] = (f32x4){0.f, 0.f, 0.f, 0.f};
    bf16x8 At[4][2], B0[2][2], B1[2][2];
    const char* cA = (const char*)g.A + (size_t)cur.pm * tstep; const char* cB = (const char*)g.Bt + (size_t)cur.pn * tstep;
    S.a_ready(cur);
    if constexpr (SP2) {
        PG8_STAGE(PG8_SB(0, 0), cB, voffB); PG8_STAGE(PG8_SB(0, 1), cB + hstep, voffB); PG8_STAGE(PG8_SA(0, 0), cA, voffA); PG8_STAGE(PG8_SA(0, 1), cA + hstep, voffA);
        if (wr == 1) PG8_BAR;
        PG8_WAIT_V(2); PG8_BAR;
        PG8_STAGE(PG8_SB(1, 0), cB + kstep, voffB); PG8_STAGE(PG8_SA(1, 0), cA + kstep, voffA); PG8_STAGE(PG8_SB(1, 1), cB + hstep + kstep, voffB);
        PG8_WAIT_V(6); PG8_BAR;
    } else {
        PG8_STAGE(PG8_SB(0, 0), cB, voffB); PG8_STAGE(PG8_SA(0, 0), cA, voffA); PG8_STAGE(PG8_SB(0, 1), cB + hstep, voffB); PG8_STAGE(PG8_SA(0, 1), cA + hstep, voffA);
        if (wr == 1) PG8_BAR;
        PG8_WAIT_V(4); PG8_BAR;
        PG8_STAGE(PG8_SB(1, 0), cB + kstep, voffB); PG8_STAGE(PG8_SA(1, 0), cA + kstep, voffA); PG8_STAGE(PG8_SB(1, 1), cB + hstep + kstep, voffB);
        PG8_WAIT_V(6); PG8_BAR;
    }
    for (;;) {
        const bool has_next = S.next(ui + 1, nxt);
        const char* nA = has_next ? (const char*)g.A + (size_t)nxt.pm * tstep : cA; const char* nB = has_next ? (const char*)g.Bt + (size_t)nxt.pn * tstep : cB;
        for (int t = 0; t < nt; t += 2) {
            const bool last = (t == nt - 2);
            const char* a1 = cA + (size_t)(t + 1) * kstep;
            const char* a2 = last ? nA : cA + (size_t)(t + 2) * kstep; const char* b2 = last ? nB : cB + (size_t)(t + 2) * kstep;
            const char* a3 = a2 + kstep; const char* b3 = b2 + kstep;
            if (last && has_next) S.a_ready(nxt);
            if constexpr (SP2) {
            PG8_LDB(B0, 0, 0); PG8_LDB(B1, 0, 1); PG8_SCHED; PG8_LDA(At, 0, 0); PG8_STAGE(PG8_SA(1, 1), a1 + hstep, voffA);
            PG8_WAIT_V(8); PG8_WAIT_L(0); PG8_BAR; PG8_MMA(0, 0, At, B0); PG8_MMA(0, 1, At, B1); PG8_BAR; PG8_SCHED;
            PG8_LDA(At, 0, 1); PG8_STAGE(PG8_SB(0, 0), b2, voffB); PG8_STAGE(PG8_SB(0, 1), b2 + hstep, voffB); PG8_STAGE(PG8_SA(0, 0), a2, voffA);
            PG8_WAIT_V(8); PG8_WAIT_L(0); PG8_BAR; PG8_MMA(1, 0, At, B0); PG8_MMA(1, 1, At, B1); PG8_BAR; PG8_SCHED;
            PG8_LDB(B0, 1, 0); PG8_LDB(B1, 1, 1); PG8_SCHED; PG8_LDA(At, 1, 0); PG8_STAGE(PG8_SA(0, 1), a2 + hstep, voffA);
            PG8_WAIT_V(8); PG8_WAIT_L(0); PG8_BAR; PG8_MMA(0, 0, At, B0); PG8_MMA(0, 1, At, B1); PG8_BAR; PG8_SCHED;
            PG8_LDA(At, 1, 1); PG8_STAGE(PG8_SB(1, 0), b3, voffB); PG8_STAGE(PG8_SB(1, 1), b3 + hstep, voffB); PG8_STAGE(PG8_SA(1, 0), a3, voffA);
            PG8_WAIT_V(8); PG8_WAIT_L(0); PG8_BAR; PG8_MMA(1, 0, At, B0); PG8_MMA(1, 1, At, B1); PG8_BAR; PG8_SCHED;
            } else {
            PG8_LDB(B0, 0, 0); PG8_SCHED; PG8_LDA(At, 0, 0); PG8_STAGE(PG8_SA(1, 1), a1 + hstep, voffA);
            PG8_WAIT_L(8); PG8_BAR; PG8_WAIT_L(0); PG8_MMA(0, 0, At, B0); PG8_BAR; PG8_SCHED;
            PG8_LDB(B1, 0, 1); PG8_STAGE(PG8_SB(0, 0), b2, voffB);
            PG8_BAR; PG8_WAIT_L(0); PG8_MMA(0, 1, At, B1); PG8_BAR;
            PG8_LDA(At, 0, 1); PG8_STAGE(PG8_SA(0, 0), a2, voffA);
            PG8_BAR; PG8_WAIT_L(0); PG8_MMA(1, 0, At, B0); PG8_BAR; PG8_SCHED;
            PG8_STAGE(PG8_SB(0, 1), b2 + hstep, voffB);
            PG8_WAIT_V(6); PG8_BAR; PG8_MMA(1, 1, At, B1); PG8_BAR;
            PG8_LDB(B0, 1, 0); PG8_SCHED; PG8_LDA(At, 1, 0); PG8_STAGE(PG8_SA(0, 1), a2 + hstep, voffA);
            PG8_WAIT_L(8); PG8_BAR; PG8_WAIT_L(0); PG8_MMA(0, 0, At, B0); PG8_BAR; PG8_SCHED;
            PG8_LDB(B1, 1, 1); PG8_STAGE(PG8_SB(1, 0), b3, voffB);
            PG8_BAR; PG8_WAIT_L(0); PG8_MMA(0, 1, At, B1); PG8_BAR;
            PG8_LDA(At, 1, 1); PG8_STAGE(PG8_SA(1, 0), a3, voffA);
            PG8_BAR; PG8_WAIT_L(0); PG8_MMA(1, 0, At, B0); PG8_BAR; PG8_SCHED;
            PG8_STAGE(PG8_SB(1, 1), b3 + hstep, voffB);
            PG8_WAIT_V(6); PG8_BAR; PG8_MMA(1, 1, At, B1); PG8_BAR;
            }
        }
        if constexpr (ALIGN_EPI) { if (wr == 0) PG8_BAR; }
        if constexpr (!Epi::AFTER_DRAIN) { E(acc, cur, wr, wc, fr, fq); S.done(cur); }
        if (!has_next) break;
#pragma unroll
        for (int a = 0; a < 2; ++a)
#pragma unroll
            for (int b = 0; b < 2; ++b)
#pragma unroll
                for (int m = 0; m < 4; ++m)
#pragma unroll
                    for (int n = 0; n < 2; ++n) acc[a][b][m][n] = (f32x4){0.f, 0.f, 0.f, 0.f};
        cur = nxt; cA = nA; cB = nB; ++ui;
        if constexpr (ALIGN_EPI) { if (wr == 1) PG8_BAR; }
    }
    PG8_WAIT_V(0);
    if constexpr (!ALIGN_EPI) { if (wr == 0) PG8_BAR; }
    PG8_BAR;
    if constexpr (Epi::AFTER_DRAIN) { E.fused(acc, cur, wr, wc, fr, fq, lds, wid, lane); S.done(cur); }
#undef PG8_SA
#undef PG8_SB
#undef PG8_STAGE
#undef PG8_LDA
#undef PG8_LDB
#undef PG8_MMA
#undef PG8_WAIT_V
#undef PG8_WAIT_L
#undef PG8_BAR
#undef PG8_SCHED
}
}
#ifndef PG8_SP2
#define PG8_SP2 true
#endif
#ifndef PG8_ALIGN
#define PG8_ALIGN true
#endif
#ifndef REP_IN
#define REP_IN 1
#endif
#ifndef REP_OUT
#define REP_OUT 1
#endif
#ifndef REP_LN
#define REP_LN 1
#endif
#ifndef REP_P0
#define REP_P0 1
#endif
#ifndef MK_MULTI
#define MK_MULTI 0
#endif

constexpr int NWAVES = 8, NTHR = NWAVES * 64;
constexpr int BATCH = 2, T = 4096, D = 2048, M = BATCH * T, FF = 5632, DEPTH = 4;
constexpr int LRU_W = 1024, EVEN_IN = 3328, ODD_IN = 6160, ODD_N = 6144;
constexpr int GLA_DK = 1024, GLA_DV = 2048, GLA_HK = 256, GLA_HV = 512;
constexpr float DN_ALPHA = 1.6817928305074290f;
constexpr float LN_EPS = 1e-5f, RMS_EPS = 1e-6f;
constexpr int NSUB = 12, SLOTS = 6, NPHASE = 1 + NSUB * SLOTS;

constexpr size_t MiB = 1u << 20;
constexpr size_t WS_CTL = 0, CTL_ZERO_BYTES = 1 * MiB;
constexpr size_t WS_WGU = 1 * MiB, SZ_WGU = 44 * MiB;
constexpr size_t WS_WD = WS_WGU + 8 * SZ_WGU, SZ_WD = 22 * MiB;
constexpr size_t WS_WEIN = WS_WD + 8 * SZ_WD, SZ_WEIN = 13 * MiB;
constexpr size_t WS_WEOUT = WS_WEIN + 2 * SZ_WEIN, SZ_WOUT = 8 * MiB;
constexpr size_t WS_WOIN = WS_WEOUT + 2 * SZ_WOUT, SZ_WOIN = 24 * MiB;
constexpr size_t WS_WOOUT = WS_WOIN + 2 * SZ_WOIN;
constexpr size_t WS_X = WS_WOOUT + 2 * SZ_WOUT;
constexpr size_t WS_Y = WS_X + 64 * MiB;
constexpr size_t WS_XB = WS_Y + 64 * MiB;
constexpr size_t WS_H = WS_XB + 32 * MiB;
constexpr size_t WS_PROJ = WS_H + 88 * MiB;
constexpr size_t WS_MIX = WS_PROJ + 96 * MiB;
constexpr size_t WS_S0 = WS_MIX + 32 * MiB;
constexpr size_t WS_LRU_A = WS_S0, WS_LRU_U = WS_S0 + 32 * MiB, WS_LRU_SUM = WS_S0 + 64 * MiB;
constexpr size_t WS_GLA_ALR = WS_S0, WS_GLA_G = WS_S0 + 1 * MiB, WS_GLA_O = WS_S0 + 33 * MiB;
constexpr size_t WS_GLA_QT = WS_S0 + 97 * MiB, WS_GLA_KT = WS_GLA_QT + 16 * MiB, WS_GLA_VT = WS_GLA_KT + 16 * MiB, WS_GLA_AI = WS_GLA_VT + 32 * MiB, WS_GLA_GAM = WS_GLA_AI + 4 * MiB;
constexpr size_t WS_WALR = WS_GLA_GAM + 1 * MiB;
constexpr size_t WS_GLA_SS = WS_WALR + 1 * MiB;
constexpr size_t WS_END = WS_GLA_SS + 128 * MiB;
constexpr int CW_TMO = 0, CW_CODE = 1, CW_BAR = 4096;

constexpr int RING_OFF = 0, RING_BYTES = 131072;
constexpr int LDSCTL_OFF = RING_BYTES, MISC_OFF = LDSCTL_OFF + 320, SCR_OFF = LDSCTL_OFF + 512;
constexpr int LDS_BYTES = 147456;

#define GAS __attribute__((address_space(1)))
#define LAS __attribute__((address_space(3)))
typedef unsigned short bf16;
typedef unsigned v4u __attribute__((ext_vector_type(4)));
typedef unsigned v2u __attribute__((ext_vector_type(2)));
typedef float f32x4 __attribute__((ext_vector_type(4)));
typedef GAS unsigned gu32;
#define RLX_AGENT __ATOMIC_RELAXED, __HIP_MEMORY_SCOPE_AGENT
#define LDS_WAIT() asm volatile("s_waitcnt lgkmcnt(0)" ::: "memory")
#define VM_WAIT() asm volatile("s_waitcnt vmcnt(0)" ::: "memory")
__device__ __forceinline__ unsigned f2bf(float f) { unsigned u = __builtin_bit_cast(unsigned, f); return (u + 0x7fffu + ((u >> 16) & 1u)) >> 16; }
__device__ __forceinline__ unsigned pk2(float lo, float hi) { return f2bf(lo) | (f2bf(hi) << 16); }
__device__ __forceinline__ float bflo(unsigned w) { return __builtin_bit_cast(float, w << 16); }
__device__ __forceinline__ float bfhi(unsigned w) { return __builtin_bit_cast(float, w & 0xffff0000u); }
__device__ __forceinline__ float bf2f(bf16 b) { return __builtin_bit_cast(float, (unsigned)b << 16); }
__device__ __forceinline__ float sigmoid_f(float x) { return 1.0f / (1.0f + __expf(-x)); }

#define XB_TMO      128
#define XB_XCNT(j)  (256  + 64 * (j))
#define XB_XSUB(j)  (1280 + 64 * (j))
#define XB_XGEN(j)  (2304 + 64 * (j))
#define XB_TOP      3328
#define XB_TOPGEN   3392
#define XCD_BAR_WORDS 3456
#define XB_SPIN_CAP (1u << 18)

__device__ __forceinline__ unsigned xb_ld(unsigned* p)              { return __hip_atomic_load(p, __ATOMIC_RELAXED, __HIP_MEMORY_SCOPE_AGENT); }
__device__ __forceinline__ unsigned xb_add(unsigned* p, unsigned v) { return __hip_atomic_fetch_add(p, v, __ATOMIC_RELAXED, __HIP_MEMORY_SCOPE_AGENT); }
__device__ __forceinline__ unsigned xb_xcc_id() { return (unsigned)__builtin_amdgcn_s_getreg((3 << 11) | 20) & 0xFu; }
#define XB_SPIN(cond, bar) do { unsigned _sp = 0; while (cond) { __builtin_amdgcn_s_sleep(1); \
    if ((++_sp & 255u) == 0u) { if (xb_ld(&(bar)[XB_TMO])) break; if (_sp > XB_SPIN_CAP) { atomicAdd(&(bar)[XB_TMO], 1u); break; } } } } while (0)

struct XcdBarrier {
    unsigned* bar; unsigned x;
    volatile LAS unsigned* st;
};

__device__ __forceinline__ XcdBarrier xcd_barrier_post(unsigned* bar, volatile LAS unsigned* st) {
    XcdBarrier b; b.bar = bar; b.x = xb_xcc_id(); b.st = st;
    if (threadIdx.x == 0) (void)xb_add(&bar[XB_XCNT(b.x)], 1u);
    return b;
}
__device__ __forceinline__ void xcd_barrier_complete(unsigned* bar, unsigned x, unsigned& nloc, unsigned& nx) {
    const unsigned G = gridDim.x * gridDim.y * gridDim.z;
    unsigned sum, cnt, mine, sp = 0u;
    for (;;) {
        sum = 0u; cnt = 0u; mine = 0u;
#pragma unroll
        for (unsigned j = 0; j < 16; ++j) { const unsigned c = xb_ld(&bar[XB_XCNT(j)]); sum += c; cnt += (c > 0u) ? 1u : 0u; mine = (j == x) ? c : mine; }
        if (sum == G) break;
        __builtin_amdgcn_s_sleep(1);
        if ((++sp & 255u) == 0u) { if (xb_ld(&bar[XB_TMO])) break; if (sp > XB_SPIN_CAP) { atomicAdd(&bar[XB_TMO], 1u); break; } }
    }
    nloc = mine > 0u ? mine : 1u; nx = cnt > 0u ? cnt : 1u;
}

__device__ __forceinline__ void xcd_barrier(const XcdBarrier& b) {
    asm volatile("s_waitcnt vmcnt(0)" ::: "memory");
    __syncthreads();
    if (threadIdx.x == 0) {
        unsigned* bar = b.bar;
        __builtin_amdgcn_s_waitcnt(0);
        unsigned nloc = b.st[0], nx = b.st[1];
        if (nloc == 0u) { xcd_barrier_complete(bar, b.x, nloc, nx); b.st[0] = nloc; b.st[1] = nx; }
        const unsigned old = xb_add(&bar[XB_XSUB(b.x)], 1u);
        const unsigned gen = old / nloc;
        if (old + 1u == (gen + 1u) * nloc) {
            __builtin_amdgcn_fence(__ATOMIC_RELEASE, "agent");
            asm volatile("s_waitcnt vmcnt(0)" ::: "memory");
            const unsigned og = xb_add(&bar[XB_TOP], 1u);
            const unsigned tg = og / nx;
            if (og + 1u == (tg + 1u) * nx) xb_add(&bar[XB_TOPGEN], 1u);
            else XB_SPIN(xb_ld(&bar[XB_TOPGEN]) == tg, bar);
            __builtin_amdgcn_fence(__ATOMIC_ACQUIRE, "agent");
            xb_add(&bar[XB_XGEN(b.x)], 1u);
            asm volatile("s_waitcnt vmcnt(0)" ::: "memory");
        } else {
            XB_SPIN(xb_ld(&bar[XB_XGEN(b.x)]) == gen, bar);
            __builtin_amdgcn_fence(__ATOMIC_ACQUIRE, "agent");
            asm volatile("s_waitcnt vmcnt(0)" ::: "memory");
        }
    }
    __syncthreads();
}


struct Frame {
    LAS unsigned char* lds;
    volatile LAS unsigned* MISC;
    gu32* ctl;
    int tid, lane, wave, vcu, G;
    const float *xin, *w_gate, *w_up, *w_down, *ln_g, *ln_b, *even_w_in, *conv_w, *conv_b, *lru_wa, *lru_ba, *lru_wx, *lru_bx, *lru_lambda, *swa_sinks, *even_w_out, *rel_bias,
                *odd_w_in, *gla_w_alpha2, *gla_b_alpha, *gla_norm_g, *odd_w_out;
    float* out;
    unsigned char* ws;
};
__device__ __forceinline__ float wave_sum(float v) {
#pragma unroll
    for (int o = 1; o < 64; o <<= 1) v += __shfl_xor(v, o);
    return v;
}

__device__ __forceinline__ void transpose_item(const float* W, int ldw, int k0, int n0, bf16* WT, int K, int dst_row0, LAS float* scr, int lane) {
#pragma unroll 8
    for (int i = 0; i < 32; ++i) { const int kk = 2 * i + (lane >> 5); scr[kk * 33 + (lane & 31)] = W[(size_t)(k0 + kk) * ldw + n0 + (lane & 31)]; }
    LDS_WAIT(); asm volatile("" ::: "memory");
    const int c = lane & 7;
#pragma unroll
    for (int j = 0; j < 4; ++j) { const int n = (lane >> 3) + 8 * j; const LAS float* s = scr + (8 * c) * 33 + n;
        v4u o; o.x = pk2(s[0 * 33], s[1 * 33]); o.y = pk2(s[2 * 33], s[3 * 33]); o.z = pk2(s[4 * 33], s[5 * 33]); o.w = pk2(s[6 * 33], s[7 * 33]);
        *(GAS v4u*)(WT + (size_t)(dst_row0 + n) * K + k0 + 8 * c) = o; }
    LDS_WAIT(); asm volatile("" ::: "memory");
}
__device__ __forceinline__ void p0_prologue(Frame& F) {
    LAS float* scr = (LAS float*)(F.lds + RING_OFF + F.wave * 16384);
    const int gw = F.vcu * NWAVES + F.wave, NGW = F.G * NWAVES;
    constexpr int I_FF = (D / 64) * (FF / 32);
    constexpr int I_EIN = (D / 64) * (EVEN_IN / 32);
    constexpr int I_SQ = (D / 64) * (D / 32);
    constexpr int I_OIN = (D / 64) * (ODD_N / 32);
    constexpr int R1 = 8 * I_FF, R2 = 2 * R1, R3 = 3 * R1, R4 = R3 + 2 * I_EIN, R5 = R4 + 2 * I_SQ, R6 = R5 + 2 * I_OIN, R7 = R6 + 2 * I_SQ;
    bf16* ws16 = (bf16*)F.ws;
    for (int it = gw; it < R7; it += NGW) {
        if (it < R2) {
            const int up = it >= R1, r = it - up * R1, mi = r / I_FF, q = r % I_FF, kb = q / (FF / 32), nb = q % (FF / 32), n0 = nb * 32;
            const float* W = (up ? F.w_up : F.w_gate) + (size_t)mi * D * FF;
            transpose_item(W, FF, kb * 64, n0, (bf16*)(F.ws + WS_WGU + (size_t)mi * SZ_WGU), D, 256 * (n0 >> 7) + (n0 & 127) + up * 128, scr, F.lane);
        } else if (it < R3) {
            const int r = it - R2, mi = r / I_FF, q = r % I_FF, kb = q / (D / 32), nb = q % (D / 32);
            transpose_item(F.w_down + (size_t)mi * FF * D, D, kb * 64, nb * 32, (bf16*)(F.ws + WS_WD + (size_t)mi * SZ_WD), FF, nb * 32, scr, F.lane);
        } else if (it < R4) {
            const int r = it - R3, mi = r / I_EIN, q = r % I_EIN, kb = q / (EVEN_IN / 32), nb = q % (EVEN_IN / 32);
            transpose_item(F.even_w_in + (size_t)mi * D * EVEN_IN, EVEN_IN, kb * 64, nb * 32, (bf16*)(F.ws + WS_WEIN + (size_t)mi * SZ_WEIN), D, nb * 32, scr, F.lane);
        } else if (it < R5) {
            const int r = it - R4, mi = r / I_SQ, q = r % I_SQ, kb = q / (D / 32), nb = q % (D / 32);
            transpose_item(F.even_w_out + (size_t)mi * D * D, D, kb * 64, nb * 32, (bf16*)(F.ws + WS_WEOUT + (size_t)mi * SZ_WOUT), D, nb * 32, scr, F.lane);
        } else if (it < R6) {
            const int r = it - R5, mi = r / I_OIN, q = r % I_OIN, kb = q / (ODD_N / 32), nb = q % (ODD_N / 32);
            transpose_item(F.odd_w_in + (size_t)mi * D * ODD_IN, ODD_IN, kb * 64, nb * 32, (bf16*)(F.ws + WS_WOIN + (size_t)mi * SZ_WOIN), D, nb * 32, scr, F.lane);
        } else {
            const int r = it - R6, mi = r / I_SQ, q = r % I_SQ, kb = q / (D / 32), nb = q % (D / 32);
            transpose_item(F.odd_w_out + (size_t)mi * D * D, D, kb * 64, nb * 32, (bf16*)(F.ws + WS_WOOUT + (size_t)mi * SZ_WOUT), D, nb * 32, scr, F.lane);
        }
    }
    (void)ws16;
    { bf16* WALR = (bf16*)(F.ws + WS_WALR);
      for (int idx = gw * 64 + F.lane; idx < 2 * D * 16; idx += NGW * 64) { const int n = idx & 15, k = (idx >> 4) & (D - 1), jj = idx >> 15;
          WALR[((size_t)jj * 16 + n) * D + k] = (bf16)f2bf(F.odd_w_in[((size_t)jj * D + k) * ODD_IN + ODD_N + n]); } }
    bf16* XB = (bf16*)(F.ws + WS_XB);
    for (int m = gw; m < M; m += NGW) {
        const GAS f32x4* xr = (const GAS f32x4*)(F.xin + (size_t)m * D) + F.lane;
        GAS v2u* o8 = (GAS v2u*)(XB + (size_t)m * D) + F.lane;
#pragma unroll
        for (int j = 0; j < 8; ++j) { const f32x4 v = xr[64 * j]; v2u o; o.x = pk2(v.x, v.y); o.y = pk2(v.z, v.w); o8[64 * j] = o; }
    }
}

__device__ __forceinline__ void ln_phase(Frame& F, const float* Y, const float* g, const float* b, float* Xout, bf16* XB) {
    const int gw = F.vcu * NWAVES + F.wave, NGW = F.G * NWAVES;
    for (int m = gw; m < M; m += NGW) {
        const GAS f32x4* yr = (const GAS f32x4*)(Y + (size_t)m * D) + F.lane;
        f32x4 v[8]; float s = 0.f;
#pragma unroll
        for (int j = 0; j < 8; ++j) { v[j] = yr[64 * j]; s += (v[j].x + v[j].y) + (v[j].z + v[j].w); }
        const float mean = wave_sum(s) * (1.f / D); float s2 = 0.f;
#pragma unroll
        for (int j = 0; j < 8; ++j) { v[j] = v[j] - mean; s2 += (v[j].x * v[j].x + v[j].y * v[j].y) + (v[j].z * v[j].z + v[j].w * v[j].w); }
        const float rstd = 1.f / sqrtf(wave_sum(s2) * (1.f / D) + LN_EPS);
        GAS f32x4* xo = (GAS f32x4*)(Xout + (size_t)m * D) + F.lane;
        GAS v2u* o8 = (GAS v2u*)(XB + (size_t)m * D) + F.lane;
        const GAS f32x4* gp = (const GAS f32x4*)g + F.lane; const GAS f32x4* bp = (const GAS f32x4*)b + F.lane;
#pragma unroll
        for (int j = 0; j < 8; ++j) { const f32x4 o = v[j] * rstd * gp[64 * j] + bp[64 * j]; xo[64 * j] = o; v2u w; w.x = pk2(o.x, o.y); w.y = pk2(o.z, o.w); o8[64 * j] = w; }
    }
}

__device__ __forceinline__ void lru_local_phase(Frame& F, int j) {
    LAS float* xin = (LAS float*)(F.lds + RING_OFF);
    LAS float* xc = xin + 67 * 64;
    LAS float* wa = xc + 64 * 65;
    LAS float* wx = wa + 4096;
    LAS float* sa = wx + 4096;
    LAS float* su = sa + 4096;
    const bf16* PROJ = (const bf16*)(F.ws + WS_PROJ);
    float* Abuf = (float*)(F.ws + WS_LRU_A); float* Ubuf = (float*)(F.ws + WS_LRU_U); float* SUM = (float*)(F.ws + WS_LRU_SUM);
    const float* cw = F.conv_w + (size_t)j * 4 * LRU_W; const float* cb = F.conv_b + (size_t)j * LRU_W;
    const float* ba = F.lru_ba + (size_t)j * LRU_W; const float* bx = F.lru_bx + (size_t)j * LRU_W; const float* lam = F.lru_lambda + (size_t)j * LRU_W;
    const int tid = F.tid;
    for (int unit = blockIdx.x; unit < 2048; unit += F.G) {
        const int hh = unit & 15, c = (unit >> 4) & 63, b = unit >> 10, t0 = c * 64; const size_t mrow0 = (size_t)b * T + t0;
        for (int idx = tid; idx < 67 * 64; idx += NTHR) { const int r = idx >> 6, ch = idx & 63, t = t0 - 3 + r;
            xin[idx] = t >= 0 ? bf2f(PROJ[((size_t)b * T + t) * EVEN_IN + hh * 64 + ch]) : 0.f; }
        const float* gwa = F.lru_wa + ((size_t)j * 16 + hh) * 4096; const float* gwx = F.lru_wx + ((size_t)j * 16 + hh) * 4096;
        for (int idx = tid; idx < 4096; idx += NTHR) { wa[idx] = gwa[idx]; wx[idx] = gwx[idx]; }
        __syncthreads();
        for (int idx = tid; idx < 4096; idx += NTHR) { const int t = idx >> 6, ch = idx & 63, gch = hh * 64 + ch; float acc = cb[gch];
#pragma unroll
            for (int jj = 0; jj < 4; ++jj) acc += cw[jj * LRU_W + gch] * xin[(t + jj) * 64 + ch];
            xc[t * 65 + ch] = acc; }
        __syncthreads();
        {
            const int ch = tid & 63, tg = tid >> 6, gch = hh * 64 + ch;
            float ra[8], rx[8];
#pragma unroll
            for (int tt = 0; tt < 8; ++tt) { ra[tt] = 0.f; rx[tt] = 0.f; }
            for (int i = 0; i < 64; ++i) { const float wai = wa[i * 64 + ch], wxi = wx[i * 64 + ch];
#pragma unroll
                for (int tt = 0; tt < 8; ++tt) { const float xv = xc[(tg * 8 + tt) * 65 + i]; ra[tt] += xv * wai; rx[tt] += xv * wxi; } }
            const float sp = log1pf(expf(-lam[gch])), bav = ba[gch], bxv = bx[gch];
#pragma unroll
            for (int tt = 0; tt < 8; ++tt) { const int t = tg * 8 + tt;
                const float r = sigmoid_f(ra[tt] + bav), ig = sigmoid_f(rx[tt] + bxv), la = -8.0f * r * sp, a = expf(la), uu = sqrtf(-expm1f(2.0f * la)) * (ig * xc[t * 65 + ch]);
                sa[t * 64 + ch] = a; su[t * 64 + ch] = uu; Abuf[(mrow0 + t) * LRU_W + gch] = a; Ubuf[(mrow0 + t) * LRU_W + gch] = uu; }
        }
        __syncthreads();
        if (tid < 64) { float h = 0.f, P = 1.f;
            for (int t = 0; t < 64; ++t) { const float a = sa[t * 64 + tid]; h = a * h + su[t * 64 + tid]; P *= a; }
            float* sp2 = SUM + (((size_t)b * 64 + c) * LRU_W + hh * 64 + tid) * 2; sp2[0] = P; sp2[1] = h; }
        __syncthreads();
    }
}
__device__ __forceinline__ float gelu_tanh(float x) { const float u = 0.7978845608028654f * (x + 0.044715f * x * x * x); return 0.5f * x * (1.0f + tanhf(u)); }
__device__ __forceinline__ void lru_fix_phase(Frame& F) {
    const bf16* PROJ = (const bf16*)(F.ws + WS_PROJ); bf16* MIX = (bf16*)(F.ws + WS_MIX);
    const float* Abuf = (const float*)(F.ws + WS_LRU_A); const float* Ubuf = (const float*)(F.ws + WS_LRU_U); const float* SUM = (const float*)(F.ws + WS_LRU_SUM);
    for (int unit = blockIdx.x; unit < 256; unit += F.G) {
        const int half = unit & 1, c = (unit >> 1) & 63, b = unit >> 7, ch = half * 512 + F.tid;
        float h = 0.f;
        for (int cc = 0; cc < c; ++cc) { const float* sp2 = SUM + (((size_t)b * 64 + cc) * LRU_W + ch) * 2; h = sp2[0] * h + sp2[1]; }
        const size_t m0 = (size_t)b * T + c * 64;
        for (int t = 0; t < 64; ++t) { const size_t m = m0 + t; h = Abuf[m * LRU_W + ch] * h + Ubuf[m * LRU_W + ch];
            const float ga = bf2f(PROJ[m * EVEN_IN + LRU_W + ch]);
            MIX[m * D + ch] = (bf16)f2bf(gelu_tanh(ga) * h); }
    }
}
__device__ __forceinline__ void swa_phase(Frame& F, int j) {
    LAS float* Ks = (LAS float*)(F.lds + RING_OFF);
    LAS float* Vs = Ks + 256 * 64;
    LAS float* btab = (LAS float*)(F.lds + SCR_OFF);
    const bf16* PROJ = (const bf16*)(F.ws + WS_PROJ); bf16* MIX = (bf16*)(F.ws + WS_MIX);
    const int tid = F.tid, lane = F.lane, w = F.wave;
    for (int unit = blockIdx.x; unit < 256; unit += F.G) {
        const int half = unit & 1, kvh = (unit >> 1) & 1, nb = (unit >> 2) & 31, b = unit >> 7, hq = kvh * 8 + w;
        __syncthreads();
        for (int idx = tid; idx < 8 * 128; idx += NTHR) { const int hh = idx >> 7, d = idx & 127;
            int bucket = d; if (d >= 16) { bucket = 16 + (int)(logf((float)d * (1.0f / 16.0f)) / 2.0794415416798357f * 16.0f); bucket = bucket > 31 ? 31 : bucket; }
            btab[idx] = F.rel_bias[bucket * 16 + kvh * 8 + hh]; }
        for (int idx = tid; idx < 2048; idx += NTHR) { const int r = idx >> 3, c8 = idx & 7, kabs = nb * 128 + r - 128;
            v4u kk = (v4u){0u, 0u, 0u, 0u}, vv = (v4u){0u, 0u, 0u, 0u};
            if (kabs >= 0) { const bf16* rowp = PROJ + ((size_t)b * T + kabs) * EVEN_IN; kk = *(const GAS v4u*)(rowp + 3072 + kvh * 64 + c8 * 8); vv = *(const GAS v4u*)(rowp + 3200 + kvh * 64 + c8 * 8); }
            LAS float* kd = Ks + r * 64 + c8 * 8; LAS float* vd = Vs + r * 64 + c8 * 8;
            kd[0] = bflo(kk.x); kd[1] = bfhi(kk.x); kd[2] = bflo(kk.y); kd[3] = bfhi(kk.y); kd[4] = bflo(kk.z); kd[5] = bfhi(kk.z); kd[6] = bflo(kk.w); kd[7] = bfhi(kk.w);
            vd[0] = bflo(vv.x); vd[1] = bfhi(vv.x); vd[2] = bflo(vv.y); vd[3] = bfhi(vv.y); vd[4] = bflo(vv.z); vd[5] = bfhi(vv.z); vd[6] = bflo(vv.w); vd[7] = bfhi(vv.w); }
        __syncthreads();
        const int i = half * 64 + lane; const size_t m = (size_t)b * T + nb * 128 + i;
        float q[64], o[64];
        { const bf16* qp = PROJ + m * EVEN_IN + 2048 + hq * 64;
#pragma unroll
          for (int c8 = 0; c8 < 8; ++c8) { const v4u t = *(const GAS v4u*)(qp + c8 * 8);
              q[c8 * 8 + 0] = bflo(t.x) * 0.125f; q[c8 * 8 + 1] = bfhi(t.x) * 0.125f; q[c8 * 8 + 2] = bflo(t.y) * 0.125f; q[c8 * 8 + 3] = bfhi(t.y) * 0.125f;
              q[c8 * 8 + 4] = bflo(t.z) * 0.125f; q[c8 * 8 + 5] = bfhi(t.z) * 0.125f; q[c8 * 8 + 6] = bflo(t.w) * 0.125f; q[c8 * 8 + 7] = bfhi(t.w) * 0.125f; } }
#pragma unroll
        for (int d = 0; d < 64; ++d) o[d] = 0.f;
        float mx = F.swa_sinks[j * 16 + hq], l = 1.0f;
        const LAS float* bt = btab + w * 128;
        const int jlo = half * 64 + 1, jhi = half * 64 + 63 + 128;
        for (int jk = jlo; jk <= jhi; ++jk) {
            const LAS f32x4* kr = (const LAS f32x4*)(Ks + jk * 64); float s = 0.f;
#pragma unroll
            for (int c4 = 0; c4 < 16; ++c4) { const f32x4 kv = kr[c4]; s += q[c4 * 4] * kv.x + q[c4 * 4 + 1] * kv.y + q[c4 * 4 + 2] * kv.z + q[c4 * 4 + 3] * kv.w; }
            const int dist = i + 128 - jk; const bool ok = (dist >= 0) && (dist < 128) && (nb * 128 + jk - 128 >= 0);
            s = ok ? s + bt[dist & 127] : -__builtin_inff();
            const float mn = fmaxf(mx, s), sc = __expf(mx - mn), pe = __expf(s - mn);
            l = l * sc + pe; mx = mn;
            const LAS f32x4* vr = (const LAS f32x4*)(Vs + jk * 64);
#pragma unroll
            for (int c4 = 0; c4 < 16; ++c4) { const f32x4 vv = vr[c4]; o[c4 * 4] = o[c4 * 4] * sc + pe * vv.x; o[c4 * 4 + 1] = o[c4 * 4 + 1] * sc + pe * vv.y; o[c4 * 4 + 2] = o[c4 * 4 + 2] * sc + pe * vv.z; o[c4 * 4 + 3] = o[c4 * 4 + 3] * sc + pe * vv.w; }
        }
        const float inv = 1.0f / l;
        bf16* op = MIX + m * D + LRU_W + hq * 64;
#pragma unroll
        for (int c8 = 0; c8 < 8; ++c8) { v4u t; t.x = pk2(o[c8 * 8] * inv, o[c8 * 8 + 1] * inv); t.y = pk2(o[c8 * 8 + 2] * inv, o[c8 * 8 + 3] * inv); t.z = pk2(o[c8 * 8 + 4] * inv, o[c8 * 8 + 5] * inv); t.w = pk2(o[c8 * 8 + 6] * inv, o[c8 * 8 + 7] * inv);
            *(GAS v4u*)(op + c8 * 8) = t; }
    }
    __syncthreads();
}

__device__ __forceinline__ void gla_gate_phase(Frame& F, int j) {
    LAS float* alr = (LAS float*)(F.lds + RING_OFF);
    const float* X = (const float*)(F.ws + WS_X); float* G = (float*)(F.ws + WS_GLA_G);
    const float* W = F.odd_w_in + (size_t)j * D * ODD_IN + ODD_N;
    const float* w2 = F.gla_w_alpha2 + (size_t)j * 16 * GLA_DK; const float* bal = F.gla_b_alpha + (size_t)j * GLA_DK;
    const int tid = F.tid;
    for (int unit = blockIdx.x; unit < M / 32; unit += F.G) {
        __syncthreads();
        { const int r = tid & 15, row = tid >> 4; const float* xr = X + (size_t)(unit * 32 + row) * D; float acc = 0.f;
          for (int k = 0; k < D; k += 4) { const f32x4 xv = *(const GAS f32x4*)(xr + k);
              acc += xv.x * W[(size_t)k * ODD_IN + r] + xv.y * W[(size_t)(k + 1) * ODD_IN + r] + xv.z * W[(size_t)(k + 2) * ODD_IN + r] + xv.w * W[(size_t)(k + 3) * ODD_IN + r]; }
          alr[row * 16 + r] = acc; }
        __syncthreads();
#pragma unroll
        for (int jj = 0; jj < 2; ++jj) { const int d = tid + jj * NTHR; float wc[16];
#pragma unroll
            for (int r = 0; r < 16; ++r) wc[r] = w2[r * GLA_DK + d];
            const float bb = bal[d];
            for (int row = 0; row < 32; ++row) { float lg = bb;
#pragma unroll
                for (int r = 0; r < 16; ++r) lg += alr[row * 16 + r] * wc[r];
                const float ls = fminf(lg, 0.f) - log1pf(expf(-fabsf(lg)));
                G[(size_t)(unit * 32 + row) * GLA_DK + d] = expf(ls * (1.0f / 16.0f)); } }
    }
    __syncthreads();
}
__device__ __forceinline__ void gla_scan_phase(Frame& F) {
    LAS float* red = (LAS float*)(F.lds + RING_OFF);
    const bf16* PROJ = (const bf16*)(F.ws + WS_PROJ); const float* G = (const float*)(F.ws + WS_GLA_G); float* O = (float*)(F.ws + WS_GLA_O);
    const int tid = F.tid, lane = F.lane, w = F.wave, e = tid & 15, d0 = (tid >> 4) * 8;
    for (int unit = blockIdx.x; unit < 256; unit += F.G) {
        const int es = unit & 31, h = (unit >> 5) & 3, b = unit >> 7, e0 = es * 16;
        float S[8];
#pragma unroll
        for (int i = 0; i < 8; ++i) S[i] = 0.f;
        for (int tb = 0; tb < T; tb += 8) {
            f32x4 g0[8], g1[8]; v4u kk[8], qq[8]; float vv[8];
#pragma unroll
            for (int tt = 0; tt < 8; ++tt) { const size_t m = (size_t)b * T + tb + tt; const bf16* rowp = PROJ + m * ODD_N;
                g0[tt] = *(const GAS f32x4*)(G + m * GLA_DK + h * 256 + d0); g1[tt] = *(const GAS f32x4*)(G + m * GLA_DK + h * 256 + d0 + 4);
                qq[tt] = *(const GAS v4u*)(rowp + h * 256 + d0); kk[tt] = *(const GAS v4u*)(rowp + 1024 + h * 256 + d0); vv[tt] = bf2f(rowp[2048 + h * 512 + e0 + e]); }
            __syncthreads();
#pragma unroll
            for (int tt = 0; tt < 8; ++tt) {
                const float v = vv[tt]; float part;
                S[0] = g0[tt].x * S[0] + bflo(kk[tt].x) * v; part = bflo(qq[tt].x) * S[0];
                S[1] = g0[tt].y * S[1] + bfhi(kk[tt].x) * v; part += bfhi(qq[tt].x) * S[1];
                S[2] = g0[tt].z * S[2] + bflo(kk[tt].y) * v; part += bflo(qq[tt].y) * S[2];
                S[3] = g0[tt].w * S[3] + bfhi(kk[tt].y) * v; part += bfhi(qq[tt].y) * S[3];
                S[4] = g1[tt].x * S[4] + bflo(kk[tt].z) * v; part += bflo(qq[tt].z) * S[4];
                S[5] = g1[tt].y * S[5] + bfhi(kk[tt].z) * v; part += bfhi(qq[tt].z) * S[5];
                S[6] = g1[tt].z * S[6] + bflo(kk[tt].w) * v; part += bflo(qq[tt].w) * S[6];
                S[7] = g1[tt].w * S[7] + bfhi(kk[tt].w) * v; part += bfhi(qq[tt].w) * S[7];
                part += __shfl_xor(part, 16); part += __shfl_xor(part, 32);
                if (lane < 16) red[(tt * 8 + w) * 16 + lane] = part;
            }
            __syncthreads();
            if (tid < 128) { const int tt = tid >> 4, ee = tid & 15; float s = 0.f;
#pragma unroll
                for (int ww = 0; ww < 8; ++ww) s += red[(tt * 8 + ww) * 16 + ee];
                O[((size_t)b * T + tb + tt) * GLA_DV + h * 512 + e0 + ee] = s * (1.0f / 16.0f); }
        }
    }
    __syncthreads();
}
__device__ __forceinline__ void gla_post_phase(Frame& F, int j) {
    const bf16* PROJ = (const bf16*)(F.ws + WS_PROJ); const float* O = (const float*)(F.ws + WS_GLA_O); bf16* MIX = (bf16*)(F.ws + WS_MIX);
    const float* ng = F.gla_norm_g + (size_t)j * GLA_HV;
    const int gw = F.vcu * NWAVES + F.wave, NGW = F.G * NWAVES, lane = F.lane;
    const f32x4 n0 = *(const GAS f32x4*)(ng + lane * 8), n1 = *(const GAS f32x4*)(ng + lane * 8 + 4);
    for (int it = gw; it < M * 4; it += NGW) { const int h = it & 3; const size_t m = it >> 2;
        const f32x4 a = *(const GAS f32x4*)(O + m * GLA_DV + h * 512 + lane * 8), c = *(const GAS f32x4*)(O + m * GLA_DV + h * 512 + lane * 8 + 4);
        const v4u rr = *(const GAS v4u*)(PROJ + m * ODD_N + 4096 + h * 512 + lane * 8);
        const float ss = wave_sum((a.x * a.x + a.y * a.y) + (a.z * a.z + a.w * a.w) + (c.x * c.x + c.y * c.y) + (c.z * c.z + c.w * c.w));
        const float rs = 1.0f / sqrtf(ss * (1.0f / 512.0f) + RMS_EPS);
        float r[8] = {bflo(rr.x), bfhi(rr.x), bflo(rr.y), bfhi(rr.y), bflo(rr.z), bfhi(rr.z), bflo(rr.w), bfhi(rr.w)};
        float ov[8] = {a.x * rs * n0.x, a.y * rs * n0.y, a.z * rs * n0.z, a.w * rs * n0.w, c.x * rs * n1.x, c.y * rs * n1.y, c.z * rs * n1.z, c.w * rs * n1.w};
        float y[8];
#pragma unroll
        for (int i = 0; i < 8; ++i) y[i] = ov[i] * (r[i] * sigmoid_f(r[i]));
        v4u t; t.x = pk2(y[0], y[1]); t.y = pk2(y[2], y[3]); t.z = pk2(y[4], y[5]); t.w = pk2(y[6], y[7]);
        *(GAS v4u*)(MIX + m * D + h * 512 + lane * 8) = t; }
}

typedef short bf16x8 __attribute__((ext_vector_type(8)));
#define MFMA16(a, b, c) __builtin_amdgcn_mfma_f32_16x16x32_bf16((a), (b), (c), 0, 0, 0)
__device__ __forceinline__ float log_sigmoid_fast(float x) { return fminf(x, 0.f) - __logf(1.0f + __expf(-fabsf(x))); }
__device__ __forceinline__ void gla_pre_phase(Frame& F, int j) {
    LAS unsigned char* L = F.lds + RING_OFF;
    LAS bf16* vts = (LAS bf16*)L;
    LAS float* part = (LAS float*)L;
    LAS float* alr = (LAS float*)(L + 32768);
    LAS float* tot = (LAS float*)(L + 36864);
    LAS bf16* qt = (LAS bf16*)(L + 40960);
    LAS bf16* kb = (LAS bf16*)(L + 74752);
    const bf16* PROJ = (const bf16*)(F.ws + WS_PROJ); const bf16* XB = (const bf16*)(F.ws + WS_XB);
    bf16* QT = (bf16*)(F.ws + WS_GLA_QT); bf16* KT = (bf16*)(F.ws + WS_GLA_KT); bf16* VT = (bf16*)(F.ws + WS_GLA_VT); bf16* AI = (bf16*)(F.ws + WS_GLA_AI); float* GAM = (float*)(F.ws + WS_GLA_GAM);
    const bf16* WALR = (const bf16*)(F.ws + WS_WALR) + (size_t)j * 16 * D;
    const float* w2 = F.gla_w_alpha2 + (size_t)j * 16 * GLA_DK; const float* bal = F.gla_b_alpha + (size_t)j * GLA_DK;
    const int tid = F.tid, lane = F.lane, w = F.wave, g = lane >> 4, fr = lane & 15;
    for (int unit = blockIdx.x; unit < 512; unit += F.G) {
        const int c = unit & 63, h = (unit >> 6) & 3, b = unit >> 8, u = (b * 4 + h) * 64 + c; const size_t m0 = (size_t)b * T + c * 64;
        __syncthreads();
#pragma unroll
        for (int i = 0; i < 8; ++i) { const int idx = tid + NTHR * i, row = idx >> 6, c16 = idx & 63;
            *(LAS v4u*)(vts + row * 520 + c16 * 8) = *(const GAS v4u*)(PROJ + (m0 + row) * ODD_N + 2048 + h * 512 + c16 * 8); }
        __syncthreads();
#pragma unroll
        for (int i = 0; i < 8; ++i) { const int idx = tid + NTHR * i, e = idx >> 3, sg = idx & 7; const LAS bf16* s = vts + (sg * 8) * 520 + e;
            v4u o; o.x = (unsigned)s[0] | ((unsigned)s[520] << 16); o.y = (unsigned)s[2 * 520] | ((unsigned)s[3 * 520] << 16); o.z = (unsigned)s[4 * 520] | ((unsigned)s[5 * 520] << 16); o.w = (unsigned)s[6 * 520] | ((unsigned)s[7 * 520] << 16);
            *(GAS v4u*)(VT + ((size_t)u * 512 + e) * 64 + sg * 8) = o; }
        __syncthreads();
        { f32x4 acc[4];
#pragma unroll
          for (int rt = 0; rt < 4; ++rt) acc[rt] = (f32x4){0.f, 0.f, 0.f, 0.f};
#pragma unroll
          for (int ks = 0; ks < 8; ++ks) { const int kk = 256 * w + 32 * ks + 8 * g;
              const bf16x8 bfr = *(const GAS bf16x8*)(WALR + (size_t)fr * D + kk);
#pragma unroll
              for (int rt = 0; rt < 4; ++rt) { const bf16x8 afr = *(const GAS bf16x8*)(XB + (m0 + 16 * rt + fr) * D + kk); acc[rt] = MFMA16(afr, bfr, acc[rt]); } }
#pragma unroll
          for (int rt = 0; rt < 4; ++rt)
#pragma unroll
              for (int r = 0; r < 4; ++r) part[w * 1024 + (16 * rt + 4 * g + r) * 16 + fr] = acc[rt][r]; }
        __syncthreads();
#pragma unroll
        for (int i = 0; i < 2; ++i) { const int idx = tid + NTHR * i; float s = 0.f;
#pragma unroll
            for (int ww = 0; ww < 8; ++ww) s += part[ww * 1024 + idx];
            alr[idx] = s; }
        __syncthreads();
        {
            const int d = tid & 255, hf = tid >> 8, hd = h * 256 + d;
            float w2c[16];
#pragma unroll
            for (int r = 0; r < 16; ++r) w2c[r] = w2[r * GLA_DK + hd];
            const float bias = bal[hd];
#define GLA_LOGDECAY(t_, out_) do { float lg_ = bias; \
                _Pragma("unroll") for (int r4 = 0; r4 < 4; ++r4) { const f32x4 av = *(const LAS f32x4*)(alr + (t_) * 16 + r4 * 4); lg_ += av.x * w2c[r4 * 4] + av.y * w2c[r4 * 4 + 1] + av.z * w2c[r4 * 4 + 2] + av.w * w2c[r4 * 4 + 3]; } \
                out_ = log_sigmoid_fast(lg_) * (1.0f / 16.0f); } while (0)
            float run = 0.f;
#pragma unroll 4
            for (int i = 0; i < 32; ++i) { float ls; GLA_LOGDECAY(32 * hf + i, ls); run += ls; }
            tot[hf * 256 + d] = run;
            __syncthreads();
            const float blast = tot[d] + tot[256 + d];
            run = hf ? tot[d] : 0.f;
            if (hf == 0) *(GAS float*)(GAM + (size_t)u * 256 + d) = __expf(blast);
            const int x = d & 31, pos = 8 * ((x & 15) >> 2) + (x & 3) + ((x >> 4) << 2);
            const GAS bf16* pq = (const GAS bf16*)(PROJ + (m0 + 32 * hf) * ODD_N + hd);
            GAS bf16* qdst = (GAS bf16*)(QT + (m0 + 32 * hf) * GLA_DK + h * 256 + (d & ~31) + pos);
            GAS bf16* kdst = (GAS bf16*)(KT + ((size_t)u * 256 + d) * 64 + 32 * hf);
#pragma unroll 1
            for (int q4 = 0; q4 < 4; ++q4) { unsigned kh[4];
#pragma unroll
                for (int i8 = 0; i8 < 8; ++i8) { const int i = 8 * q4 + i8, t = 32 * hf + i; float ls; GLA_LOGDECAY(t, ls); run += ls;
                    const float qv = bf2f(pq[(size_t)i * ODD_N]), kv = bf2f(pq[(size_t)i * ODD_N + 1024]);
                    const unsigned bq = f2bf(qv * __expf(run) * (1.0f / 16.0f));
                    qt[t * 264 + d] = (bf16)bq; kb[t * 264 + d] = (bf16)f2bf(kv * __expf(-run));
                    qdst[(size_t)i * GLA_DK] = (bf16)bq;
                    const unsigned kq = f2bf(kv * __expf(blast - run));
                    if (i8 & 1) kh[i8 >> 1] |= kq << 16; else kh[i8 >> 1] = kq; }
                *(GAS v4u*)(kdst + 8 * q4) = (v4u){kh[0], kh[1], kh[2], kh[3]}; }
#undef GLA_LOGDECAY
        }
        __syncthreads();
#pragma unroll
        for (int q2 = 0; q2 < 2; ++q2) { const int ti = 2 * w + q2, ttile = ti >> 2, stile = ti & 3;
            f32x4 acc = (f32x4){0.f, 0.f, 0.f, 0.f};
            if (stile <= ttile) {
#pragma unroll
                for (int ks = 0; ks < 8; ++ks) { const bf16x8 a = *(const LAS bf16x8*)(kb + (16 * stile + fr) * 264 + 32 * ks + 8 * g), bq = *(const LAS bf16x8*)(qt + (16 * ttile + fr) * 264 + 32 * ks + 8 * g);
                    acc = MFMA16(a, bq, acc); } }
            const int t = 16 * ttile + fr, s0 = 16 * stile + 4 * g;
            v2u o; o.x = pk2(s0 <= t ? acc[0] : 0.f, s0 + 1 <= t ? acc[1] : 0.f); o.y = pk2(s0 + 2 <= t ? acc[2] : 0.f, s0 + 3 <= t ? acc[3] : 0.f);
            *(GAS v2u*)(AI + ((size_t)u * 64 + t) * 64 + s0) = o; }
    }
    __syncthreads();
}
__device__ __forceinline__ void gla_chain_phase(Frame& F) {
    const bf16* KT = (const bf16*)(F.ws + WS_GLA_KT); const bf16* VT = (const bf16*)(F.ws + WS_GLA_VT); const float* GAM = (const float*)(F.ws + WS_GLA_GAM); v4u* SS = (v4u*)(F.ws + WS_GLA_SS);
    const int lane = F.lane, w = F.wave, g = lane >> 4, fr = lane & 15;
    if (w < 4)
    for (int task = blockIdx.x * 4 + w; task < 1024; task += F.G * 4) {
        const int ep = task & 15, ks = (task >> 4) & 7, h = (task >> 7) & 3, b = task >> 9, e0 = ep * 32; const size_t u0 = (size_t)(b * 4 + h) * 64;
        const GAS bf16* KTb = (const GAS bf16*)(KT + (u0 * 256 + 32 * ks + fr) * 64 + 8 * g);
        const GAS bf16* VTb = (const GAS bf16*)(VT + (u0 * 512 + e0 + fr) * 64 + 8 * g);
        const GAS float* GMb = (const GAS float*)(GAM + u0 * 256 + 32 * ks + 4 * g);
        GAS v4u* SSb = (GAS v4u*)(SS + ((u0 * 8 + ks) * 32 + ep * 2) * 64 + lane);
        f32x4 S[2][2];
#pragma unroll
        for (int dt = 0; dt < 2; ++dt)
#pragma unroll
            for (int en = 0; en < 2; ++en) S[dt][en] = (f32x4){0.f, 0.f, 0.f, 0.f};
        bf16x8 kt[4][2][2], vt[4][2][2]; f32x4 gm[4][2];
#define GLA_CLOAD(i_, c_) do { \
        _Pragma("unroll") for (int dt = 0; dt < 2; ++dt) { gm[i_][dt] = *(const GAS f32x4*)(GMb + (size_t)(c_) * 256 + dt * 16); \
            _Pragma("unroll") for (int k2 = 0; k2 < 2; ++k2) { kt[i_][dt][k2] = *(const GAS bf16x8*)(KTb + (size_t)(c_) * 16384 + dt * 1024 + k2 * 32); vt[i_][dt][k2] = *(const GAS bf16x8*)(VTb + (size_t)(c_) * 32768 + dt * 1024 + k2 * 32); } } } while (0)
        GLA_CLOAD(0, 0); GLA_CLOAD(1, 1); GLA_CLOAD(2, 2); GLA_CLOAD(3, 3);
        for (int c0 = 0; c0 < 64; c0 += 4) {
#pragma unroll
            for (int i = 0; i < 4; ++i) { const int c = c0 + i;
#pragma unroll
                for (int en = 0; en < 2; ++en) { v4u p; p.x = pg8::cvt_pk_bf16(S[0][en][0], S[0][en][1]); p.y = pg8::cvt_pk_bf16(S[0][en][2], S[0][en][3]); p.z = pg8::cvt_pk_bf16(S[1][en][0], S[1][en][1]); p.w = pg8::cvt_pk_bf16(S[1][en][2], S[1][en][3]);
                    SSb[(size_t)c * 16384 + en * 64] = p; }
#pragma unroll
                for (int dt = 0; dt < 2; ++dt)
#pragma unroll
                    for (int en = 0; en < 2; ++en) { f32x4 s = S[dt][en] * gm[i][dt];
                        s = MFMA16(kt[i][dt][0], vt[i][en][0], s); s = MFMA16(kt[i][dt][1], vt[i][en][1], s); S[dt][en] = s; }
                const int cn = c + 4 < 64 ? c + 4 : 63;
                GLA_CLOAD(i, cn);
            }
        }
#undef GLA_CLOAD
    }
}
__device__ __forceinline__ void gla_out_phase(Frame& F, int j) {
    LAS float* red = (LAS float*)(F.lds + RING_OFF);
    LAS float* rsl = red + 512;
    const bf16* PROJ = (const bf16*)(F.ws + WS_PROJ); bf16* MIX = (bf16*)(F.ws + WS_MIX);
    const bf16* QT = (const bf16*)(F.ws + WS_GLA_QT); const bf16* VT = (const bf16*)(F.ws + WS_GLA_VT); const bf16* AI = (const bf16*)(F.ws + WS_GLA_AI); const v4u* SS = (const v4u*)(F.ws + WS_GLA_SS);
    const float* ng = F.gla_norm_g + (size_t)j * GLA_HV;
    const int tid = F.tid, lane = F.lane, w = F.wave, g = lane >> 4, fr = lane & 15;
    for (int unit = blockIdx.x; unit < 512; unit += F.G) {
        const int c = unit & 63, h = (unit >> 6) & 3, b = unit >> 8; const size_t u = (size_t)(b * 4 + h) * 64 + c, m0 = (size_t)b * T + c * 64;
        f32x4 acc[4][4];
#pragma unroll
        for (int tt = 0; tt < 4; ++tt)
#pragma unroll
            for (int n = 0; n < 4; ++n) acc[tt][n] = (f32x4){0.f, 0.f, 0.f, 0.f};
        const GAS v4u* SSb = (const GAS v4u*)(SS + (u * 8 * 32 + 4 * w) * 64 + lane);
        const GAS bf16* QTb = (const GAS bf16*)(QT + (m0 + fr) * GLA_DK + h * 256 + 8 * g);
#pragma unroll 2
        for (int ks = 0; ks < 8; ++ks) { bf16x8 sf[4], qf[4];
#pragma unroll
            for (int n = 0; n < 4; ++n) sf[n] = __builtin_bit_cast(bf16x8, SSb[ks * 2048 + n * 64]);
#pragma unroll
            for (int tt = 0; tt < 4; ++tt) qf[tt] = *(const GAS bf16x8*)(QTb + (size_t)tt * 16 * GLA_DK + ks * 32);
#pragma unroll
            for (int tt = 0; tt < 4; ++tt)
#pragma unroll
                for (int n = 0; n < 4; ++n) acc[tt][n] = MFMA16(sf[n], qf[tt], acc[tt][n]); }
        { const GAS bf16* VTb = (const GAS bf16*)(VT + (u * 512 + 64 * w + fr) * 64 + 8 * g);
          const GAS bf16* AIb = (const GAS bf16*)(AI + (u * 64 + fr) * 64 + 8 * g);
#pragma unroll
          for (int k2 = 0; k2 < 2; ++k2) { bf16x8 vf[4], af[4];
#pragma unroll
              for (int n = 0; n < 4; ++n) vf[n] = *(const GAS bf16x8*)(VTb + n * 1024 + k2 * 32);
#pragma unroll
              for (int tt = 0; tt < 4; ++tt) af[tt] = *(const GAS bf16x8*)(AIb + tt * 1024 + k2 * 32);
#pragma unroll
              for (int tt = 0; tt < 4; ++tt)
#pragma unroll
                  for (int n = 0; n < 4; ++n) acc[tt][n] = MFMA16(vf[n], af[tt], acc[tt][n]); } }
#pragma unroll
        for (int tt = 0; tt < 4; ++tt) { float ss = 0.f;
#pragma unroll
            for (int n = 0; n < 4; ++n) { const f32x4 a = acc[tt][n]; ss += (a[0] * a[0] + a[1] * a[1]) + (a[2] * a[2] + a[3] * a[3]); }
            ss += __shfl_xor(ss, 16); ss += __shfl_xor(ss, 32);
            if (g == 0) red[w * 64 + 16 * tt + fr] = ss; }
        __syncthreads();
        if (tid < 64) { float s = 0.f;
#pragma unroll
            for (int ww = 0; ww < 8; ++ww) s += red[ww * 64 + tid];
            rsl[tid] = 1.0f / sqrtf(s * (1.0f / 512.0f) + RMS_EPS); }
        __syncthreads();
#pragma unroll
        for (int tt = 0; tt < 4; ++tt) { const float rsv = rsl[16 * tt + fr]; const size_t m = m0 + 16 * tt + fr;
#pragma unroll
            for (int n = 0; n < 4; ++n) { const int e = 64 * w + 16 * n + 4 * g;
                const f32x4 nv = *(const GAS f32x4*)(ng + e); const v2u rr = *(const GAS v2u*)(PROJ + m * ODD_N + 4096 + h * 512 + e);
                const float r0 = bflo(rr.x), r1 = bfhi(rr.x), r2 = bflo(rr.y), r3 = bfhi(rr.y); const f32x4 a = acc[tt][n];
                v2u o; o.x = pk2(a[0] * rsv * nv.x * (r0 * sigmoid_f(r0)), a[1] * rsv * nv.y * (r1 * sigmoid_f(r1))); o.y = pk2(a[2] * rsv * nv.z * (r2 * sigmoid_f(r2)), a[3] * rsv * nv.w * (r3 * sigmoid_f(r3)));
                *(GAS v2u*)(MIX + m * D + h * 512 + e) = o; } }
        __syncthreads();
    }
}

__host__ __device__ inline bool phase_active(int p) {
    if (p == 0) return true;
    const int s = (p - 1) / SLOTS, k = (p - 1) % SLOTS, l = s / 3, kind = s % 3;
    if (k == 0 || k == 4 || k == 5) return true;
    if (kind != 1) return false;
    if ((l & 1) == 0) return k == 1 || k == 2;
    return true;
}
struct Args { const float* in[22]; float* out; unsigned char* ws; int ph_lo, ph_hi; };
__global__ void __launch_bounds__(NTHR, 2) mk_fwd(Args args) {
    extern __shared__ __attribute__((aligned(16))) unsigned char lds[];
    Frame F;
    F.lds = (LAS unsigned char*)lds;
    F.MISC = (volatile LAS unsigned*)(F.lds + MISC_OFF);
    F.tid = threadIdx.x; F.lane = F.tid & 63; F.wave = __builtin_amdgcn_readfirstlane(F.tid >> 6);
    F.G = gridDim.x; { const int bx = blockIdx.x; F.vcu = (F.G % 8 == 0) ? (bx % 8) * (F.G / 8) + bx / 8 : bx; }
    F.ws = args.ws; F.ctl = (gu32*)(args.ws + WS_CTL); F.out = args.out;
    F.xin = args.in[0]; F.w_gate = args.in[1]; F.w_up = args.in[2]; F.w_down = args.in[3]; F.ln_g = args.in[4]; F.ln_b = args.in[5]; F.even_w_in = args.in[6]; F.conv_w = args.in[7]; F.conv_b = args.in[8];
    F.lru_wa = args.in[9]; F.lru_ba = args.in[10]; F.lru_wx = args.in[11]; F.lru_bx = args.in[12]; F.lru_lambda = args.in[13]; F.swa_sinks = args.in[14]; F.even_w_out = args.in[15]; F.rel_bias = args.in[16];
    F.odd_w_in = args.in[17]; F.gla_w_alpha2 = args.in[18]; F.gla_b_alpha = args.in[19]; F.gla_norm_g = args.in[20]; F.odd_w_out = args.in[21];
    for (int u = F.tid; u < (LDS_BYTES - LDSCTL_OFF) / 4; u += NTHR) ((LAS unsigned*)(F.lds + LDSCTL_OFF))[u] = 0u;
    __syncthreads();
#if MK_MULTI
#define GRID_BAR() do { } while (0)
#else
    XcdBarrier bar = xcd_barrier_post((unsigned*)(F.ctl + CW_BAR), F.MISC + 8);
#define GRID_BAR() xcd_barrier(bar)
#endif
    const int lo = args.ph_lo, hi = args.ph_hi;
#define IN(k) (lo <= (k) && (k) < hi)
#define REFRESH() do { int t_ = threadIdx.x; asm volatile("" : "+v"(t_)); F.tid = t_; F.lane = t_ & 63; F.wave = __builtin_amdgcn_readfirstlane(t_ >> 6); unsigned char* w_ = args.ws; asm volatile("" : "+s"(w_)); F.ws = w_; } while (0)
#define SEAM(k) do { if ((k) + 1 < hi) GRID_BAR(); } while (0)
#define X ((float*)(F.ws + WS_X))
#define Y ((float*)(F.ws + WS_Y))
#define XB ((bf16*)(F.ws + WS_XB))
#define H ((bf16*)(F.ws + WS_H))
#define PROJ ((bf16*)(F.ws + WS_PROJ))
#define MIX ((bf16*)(F.ws + WS_MIX))

    for (int rep_ = 0; rep_ < REP_P0; ++rep_)
    if (IN(0)) { REFRESH(); p0_prologue(F); SEAM(0); }

    for (int s = 0; s < NSUB; ++s) {
        const int l = s / 3, kind = s % 3, j = l >> 1, pb = 1 + s * SLOTS, odd = l & 1;
        const int fi = l * 2 + (kind == 2 ? 1 : 0);
        for (int rep_ = 0; rep_ < REP_IN; ++rep_)
        if (IN(pb + 0)) {
            REFRESH();
            if (kind != 1) {
                pg8::Gemm g{XB, (const bf16*)(F.ws + WS_WGU + (size_t)fi * SZ_WGU), M, 2 * FF, D}; pg8::StaticOrder S; S.init(M, 2 * FF, F.G, (int)blockIdx.x);
                pg8::EpiSwiGLU E{H, FF};
                pg8::gemm_phase<pg8::EpiSwiGLU, pg8::StaticOrder, PG8_ALIGN, PG8_SP2>(F.lds + RING_OFF, g, S, E);
            } else {
                const int N = odd ? ODD_N : EVEN_IN;
                const bf16* Wt = odd ? (const bf16*)(F.ws + WS_WOIN + (size_t)j * SZ_WOIN) : (const bf16*)(F.ws + WS_WEIN + (size_t)j * SZ_WEIN);
                pg8::Gemm g{XB, Wt, M, N, D}; pg8::StaticOrder S; S.init(M, N, F.G, (int)blockIdx.x);
                pg8::EpiPlainBf16 E{PROJ, N};
                pg8::gemm_phase<pg8::EpiPlainBf16, pg8::StaticOrder, PG8_ALIGN, PG8_SP2>(F.lds + RING_OFF, g, S, E);
            }
            SEAM(pb + 0);
        }
        if (kind == 1) {
            if (!odd) {
                if (IN(pb + 1)) { REFRESH(); lru_local_phase(F, j); REFRESH(); swa_phase(F, j); SEAM(pb + 1); }
#ifdef DUP_EVEN1
                if (IN(pb + 1)) { REFRESH(); lru_local_phase(F, j); SEAM(pb + 1); }
#endif
#ifdef DUP_EVEN2
                if (IN(pb + 1)) { REFRESH(); swa_phase(F, j); SEAM(pb + 1); }
#endif
                if (IN(pb + 2)) { REFRESH(); lru_fix_phase(F); SEAM(pb + 2); }
#ifdef DUP_EVEN3
                if (IN(pb + 2)) { REFRESH(); lru_fix_phase(F); SEAM(pb + 2); }
#endif
            } else {
                if (IN(pb + 1)) { REFRESH(); gla_pre_phase(F, j); SEAM(pb + 1); }
#ifdef DUP_ODD1
                if (IN(pb + 1)) { REFRESH(); gla_pre_phase(F, j); SEAM(pb + 1); }
#endif
                if (IN(pb + 2)) { REFRESH(); gla_chain_phase(F); SEAM(pb + 2); }
#ifdef DUP_ODD2
                if (IN(pb + 2)) { REFRESH(); gla_chain_phase(F); SEAM(pb + 2); }
#endif
                if (IN(pb + 3)) { REFRESH(); gla_out_phase(F, j); SEAM(pb + 3); }
#ifdef DUP_ODD3
                if (IN(pb + 3)) { REFRESH(); gla_out_phase(F, j); SEAM(pb + 3); }
#endif
            }
        }
        for (int rep_ = 0; rep_ < REP_OUT; ++rep_)
        if (IN(pb + 4)) {
            REFRESH();
            const bf16* A = kind != 1 ? H : MIX; const int K = kind != 1 ? FF : D;
            const bf16* Wt = kind != 1 ? (const bf16*)(F.ws + WS_WD + (size_t)fi * SZ_WD) : (odd ? (const bf16*)(F.ws + WS_WOOUT + (size_t)j * SZ_WOUT) : (const bf16*)(F.ws + WS_WEOUT + (size_t)j * SZ_WOUT));
            pg8::Gemm g{A, Wt, M, D, K}; pg8::StaticOrder S; S.init(M, D, F.G, (int)blockIdx.x);
            pg8::EpiResid E{s == 0 ? F.xin : X, Y, D, DN_ALPHA, kind != 1 ? 0.5f : 1.0f};
            pg8::gemm_phase<pg8::EpiResid, pg8::StaticOrder, PG8_ALIGN, PG8_SP2>(F.lds + RING_OFF, g, S, E);
            SEAM(pb + 4);
        }
        for (int rep_ = 0; rep_ < REP_LN; ++rep_)
        if (IN(pb + 5)) {
            REFRESH();
            ln_phase(F, Y, F.ln_g + (size_t)(l * 3 + kind) * D, F.ln_b + (size_t)(l * 3 + kind) * D, s == NSUB - 1 ? F.out : X, XB);
            SEAM(pb + 5);
        }
    }
#undef IN
#undef SEAM
#undef X
#undef Y
#undef XB
#undef H
#undef PROJ
#undef MIX
}

extern "C" void kernel_launch(void* const* d_in, const int* in_sizes, int n_in, void* d_out, int out_size, void* d_ws, size_t ws_size, hipStream_t stream) {
    static int grid = 0;
    if (grid == 0) {
        if (n_in != 22 || in_sizes[0] != M * D || out_size != M * D || ws_size < WS_END) { fprintf(stderr, "kernel_launch: unexpected shapes (n_in %d, in0 %d, out %d, ws %zu < %zu); nothing launched\n", n_in, n_in > 0 ? in_sizes[0] : -1, out_size, ws_size, (size_t)WS_END); grid = -1; return; }
        int dev = 0, cus = 0, per_cu = 0;
        if (hipGetDevice(&dev) != hipSuccess || hipDeviceGetAttribute(&cus, hipDeviceAttributeMultiprocessorCount, dev) != hipSuccess) { grid = -1; return; }
        if (hipFuncSetAttribute((const void*)mk_fwd, hipFuncAttributeMaxDynamicSharedMemorySize, LDS_BYTES) != hipSuccess) { fprintf(stderr, "kernel_launch: hipFuncSetAttribute failed\n"); grid = -1; return; }
        if (hipOccupancyMaxActiveBlocksPerMultiprocessor(&per_cu, (const void*)mk_fwd, NTHR, LDS_BYTES) != hipSuccess || per_cu < 1) { fprintf(stderr, "kernel_launch: occupancy query says %d blocks per CU\n", per_cu); }
        (void)hipGetLastError();
        grid = cus;
    }
    if (grid < 0) return;
    (void)hipMemsetAsync((char*)d_ws + WS_CTL, 0, CTL_ZERO_BYTES, stream);
    Args a{};
    for (int i = 0; i < 22; ++i) a.in[i] = (const float*)d_in[i];
    a.out = (float*)d_out; a.ws = (unsigned char*)d_ws;
#if MK_MULTI
    for (int p = 0; p < NPHASE; ++p) { if (!phase_active(p)) continue; a.ph_lo = p; a.ph_hi = p + 1; hipLaunchKernelGGL(mk_fwd, dim3(grid), dim3(NTHR), LDS_BYTES, stream, a); }
#else
    a.ph_lo = 0; a.ph_hi = NPHASE; hipLaunchKernelGGL(mk_fwd, dim3(grid), dim3(NTHR), LDS_BYTES, stream, a);
#endif
    const hipError_t le = hipPeekAtLastError();
    if (le != hipSuccess) fprintf(stderr, "kernel_launch: launch failed: %s\n", hipGetErrorName(le));
}
```
